# Optimizing an MI355X kernel written in HIP

```python
import jax, jax.numpy as jnp
from jax import lax
import numpy as np

D_MODEL = 2048
BATCH = 1
SEQ = 8192
DEPTH = 1
DEC_BATCH = 32
DEC_SEQ = 4
PAST_LEN = 8192
PAGE_SIZE = 128

HEAD_DIM = 128
HEADS_PER_GROUP = 4
DILATED_GROUPS = ((128, 1), (512, 4), (2048, 16))
N_GROUPS = len(DILATED_GROUPS)
N_ATT_HEADS = N_GROUPS * HEADS_PER_GROUP
ATT_WIDTH = N_ATT_HEADS * HEAD_DIM
ATT_OUT_WIDTH = HEADS_PER_GROUP * HEAD_DIM
Q_BLOCK = 128
CONV_CH = D_MODEL // 2
CONV_WIDTH = 31
N_BUCKETS = 32
MAX_DISTANCE = 2048
D_FF = 5632
N_MOD = 9
EPS = 1e-6
IN_WIDTH = 2 * CONV_CH + 3 * ATT_WIDTH + 2 * D_MODEL
NEG = -1e30

kernel_name = 'macaron_conv_dilated_attn_hybrid_step'


def _t5_buckets(dist):
    n = np.asarray(dist)
    max_exact = N_BUCKETS // 2
    large = max_exact + (np.log(np.maximum(n, 1) / max_exact) / np.log(MAX_DISTANCE / max_exact)
                         * (N_BUCKETS - max_exact)).astype(np.int64)
    large = np.minimum(large, N_BUCKETS - 1)
    return np.where(n < max_exact, n, large).astype(np.int32)


def _group_biases(rel_bias):
    out = []
    for g, (w, d) in enumerate(DILATED_GROUPS):
        b = rel_bias[jnp.asarray(_t5_buckets(d * np.arange(w // d + 1)))]
        out.append(b[:, g * HEADS_PER_GROUP:(g + 1) * HEADS_PER_GROUP].T.astype(jnp.float32))
    return out


def _rms(x, g):
    xf = x.astype(jnp.float32)
    y = xf * lax.rsqrt(jnp.mean(xf * xf, axis=-1, keepdims=True) + EPS) * g.astype(jnp.float32)
    return y.astype(x.dtype)


def _modulate(h, shift, scale):
    return h * (1 + scale) + shift


def _adaln(c, w_ada, b_ada):
    m = jax.nn.silu(c) @ w_ada + b_ada
    m = m.reshape(c.shape[0], N_MOD, 1, D_MODEL)
    return [m[:, i] for i in range(N_MOD)]


def _half_ffn(x, shift, scale, gate, n_pre, n_post, w1, w3, w2):
    h = _modulate(_rms(x, n_pre), shift, scale)
    f = (jax.nn.silu(h @ w1) * (h @ w3)) @ w2
    return x + 0.5 * gate * _rms(f, n_post)


def _mixer_in(x, shift, scale, n_pre, w_in):
    B, T, _ = x.shape
    h = _modulate(_rms(x, n_pre), shift, scale)
    p = h @ w_in
    cuts = [CONV_CH, 2 * CONV_CH, 2 * CONV_CH + ATT_WIDTH, 2 * CONV_CH + 2 * ATT_WIDTH,
            2 * CONV_CH + 3 * ATT_WIDTH, 2 * CONV_CH + 3 * ATT_WIDTH + D_MODEL]
    a, b, q, k, v, gc, ga = jnp.split(p, cuts, axis=-1)
    u = a * jax.nn.sigmoid(b)
    hs = (B, T, N_GROUPS, HEADS_PER_GROUP, HEAD_DIM)
    return u, q.reshape(hs), k.reshape(hs), v.reshape(hs), gc, ga


def _dwconv(u_ext, dw_kernel, dw_bias):
    y = lax.conv_general_dilated(u_ext, dw_kernel[:, None, :], window_strides=(1,), padding='VALID',
                                 dimension_numbers=('NWC', 'WIO', 'NWC'), feature_group_count=CONV_CH)
    return y + dw_bias


def _dilated_attend(q, ks, vs, q_idx, biases):
    B, Q = q.shape[:2]
    outs, lses = [], []
    for g, (w, d) in enumerate(DILATED_GROUPS):
        m = jnp.arange(w // d + 1)
        idx = q_idx[g][:, None] - d * m[None, :]
        valid = idx >= 0
        idx = jnp.maximum(idx, 0)
        kg = jnp.take(ks[g], idx, axis=1).astype(jnp.float32)
        vg = jnp.take(vs[g], idx, axis=1).astype(jnp.float32)
        s = jnp.einsum('bqhe,bqmhe->bqhm', q[:, :, g].astype(jnp.float32), kg) * HEAD_DIM ** -0.5
        s = jnp.where(valid[None, :, None, :], s + biases[g][None, None], NEG)
        mx = jnp.max(s, axis=-1, keepdims=True)
        p = jnp.exp(s - mx)
        den = jnp.sum(p, axis=-1)
        outs.append(jnp.einsum('bqhm,bqmhe->bqhe', p, vg) / den[..., None])
        lses.append(mx[..., 0] + jnp.log(den))
    wts = jax.nn.softmax(jnp.stack(lses, 0), axis=0)
    o = jnp.einsum('gbqh,gbqhe->bqhe', wts, jnp.stack(outs, 0))
    return o.reshape(B, Q, ATT_OUT_WIDTH).astype(q.dtype)


def _prompt_attention(q, ks, vs, biases):
    B, S = q.shape[:2]
    def blk(b):
        qb = lax.dynamic_slice_in_dim(q, b * Q_BLOCK, Q_BLOCK, axis=1)
        qi = b * Q_BLOCK + jnp.arange(Q_BLOCK)
        return _dilated_attend(qb, ks, vs, [qi] * N_GROUPS, biases)
    o = lax.map(blk, jnp.arange(S // Q_BLOCK))
    return o.transpose(1, 0, 2, 3).reshape(B, S, ATT_OUT_WIDTH)


def _mixer_out(x, gate, n_post, yconv, att_o, gc, ga, ln_g, ln_b, w_conv_out, w_att_out, w_out):
    yf = yconv.astype(jnp.float32)
    mu = jnp.mean(yf, axis=-1, keepdims=True)
    var = jnp.mean(jnp.square(yf - mu), axis=-1, keepdims=True)
    yn = ((yf - mu) * lax.rsqrt(var + EPS) * ln_g.astype(jnp.float32) + ln_b.astype(jnp.float32)).astype(x.dtype)
    conv_branch = jax.nn.silu(yn) @ w_conv_out
    att_branch = att_o @ w_att_out
    merged = jax.nn.sigmoid(gc) * conv_branch + jax.nn.sigmoid(ga) * att_branch
    return x + gate * _rms(merged @ w_out, n_post)


def setup_inputs(seed: int = 0) -> dict:
    key = jax.random.key(seed)
    ks = iter(jax.random.split(key, 48))
    def nrm(shape, s):
        return jax.random.normal(next(ks), shape, jnp.float32) * s
    def gain(shape):
        return 1.0 + nrm(shape, 0.02)
    inp = {}
    inp['x_prompt'] = nrm((BATCH, SEQ, D_MODEL), 1.0)
    inp['x_sample'] = nrm((DEC_BATCH, DEC_SEQ, D_MODEL), 1.0)
    for w, d in DILATED_GROUPS:
        L = min(w, PAST_LEN)
        inp[f'cache_k_w{w}'] = nrm((DEPTH, DEC_BATCH, L, HEADS_PER_GROUP, HEAD_DIM), 1.0)
        inp[f'cache_v_w{w}'] = nrm((DEPTH, DEC_BATCH, L, HEADS_PER_GROUP, HEAD_DIM), 1.0)
    inp['state_conv'] = nrm((DEPTH, DEC_BATCH, CONV_WIDTH - 1, CONV_CH), 0.5)
    inp['c_prompt'] = nrm((BATCH, D_MODEL), 1.0)
    inp['c_sample'] = nrm((DEC_BATCH, D_MODEL), 1.0)
    inp['w_ada'] = nrm((DEPTH, D_MODEL, N_MOD * D_MODEL), 0.5 * D_MODEL ** -0.5)
    inp['b_ada'] = nrm((DEPTH, N_MOD * D_MODEL), 0.02)
    inp['ffn1_norm_pre'] = gain((DEPTH, D_MODEL))
    inp['ffn1_norm_post'] = gain((DEPTH, D_MODEL))
    inp['ffn1_w1'] = nrm((DEPTH, D_MODEL, D_FF), D_MODEL ** -0.5)
    inp['ffn1_w3'] = nrm((DEPTH, D_MODEL, D_FF), D_MODEL ** -0.5)
    inp['ffn1_w2'] = nrm((DEPTH, D_FF, D_MODEL), D_FF ** -0.5)
    inp['mix_norm_pre'] = gain((DEPTH, D_MODEL))
    inp['mix_norm_post'] = gain((DEPTH, D_MODEL))
    inp['w_in'] = nrm((DEPTH, D_MODEL, IN_WIDTH), D_MODEL ** -0.5)
    inp['dw_kernel'] = nrm((DEPTH, CONV_WIDTH, CONV_CH), CONV_WIDTH ** -0.5)
    inp['dw_bias'] = nrm((DEPTH, CONV_CH), 0.02)
    inp['conv_ln_g'] = gain((DEPTH, CONV_CH))
    inp['conv_ln_b'] = nrm((DEPTH, CONV_CH), 0.02)
    inp['w_conv_out'] = nrm((DEPTH, CONV_CH, D_MODEL), CONV_CH ** -0.5)
    inp['w_att_out'] = nrm((DEPTH, ATT_OUT_WIDTH, D_MODEL), ATT_OUT_WIDTH ** -0.5)
    inp['w_out'] = nrm((DEPTH, D_MODEL, D_MODEL), D_MODEL ** -0.5)
    inp['rel_bias'] = nrm((N_BUCKETS, N_ATT_HEADS), 0.3)
    inp['ffn2_norm_pre'] = gain((DEPTH, D_MODEL))
    inp['ffn2_norm_post'] = gain((DEPTH, D_MODEL))
    inp['ffn2_w1'] = nrm((DEPTH, D_MODEL, D_FF), D_MODEL ** -0.5)
    inp['ffn2_w3'] = nrm((DEPTH, D_MODEL, D_FF), D_MODEL ** -0.5)
    inp['ffn2_w2'] = nrm((DEPTH, D_FF, D_MODEL), D_FF ** -0.5)
    return inp


def reference(x_prompt, x_sample, cache_k_w128, cache_v_w128, cache_k_w512, cache_v_w512,
              cache_k_w2048, cache_v_w2048, state_conv, c_prompt, c_sample,
              w_ada, b_ada, ffn1_norm_pre, ffn1_norm_post, ffn1_w1, ffn1_w3, ffn1_w2,
              mix_norm_pre, mix_norm_post, w_in, dw_kernel, dw_bias, conv_ln_g, conv_ln_b,
              w_conv_out, w_att_out, w_out, rel_bias,
              ffn2_norm_pre, ffn2_norm_post, ffn2_w1, ffn2_w3, ffn2_w2):
    biases = _group_biases(rel_bias)
    cache_k = [cache_k_w128, cache_k_w512, cache_k_w2048]
    cache_v = [cache_v_w128, cache_v_w512, cache_v_w2048]
    xp, xs = x_prompt, x_sample
    pk = [[] for _ in range(N_GROUPS)]; pv = [[] for _ in range(N_GROUPS)]
    sk = [[] for _ in range(N_GROUPS)]; sv = [[] for _ in range(N_GROUPS)]
    pconv_l, sconv_l = [], []
    for l in range(DEPTH):
        mp = _adaln(c_prompt, w_ada[l], b_ada[l])
        ms = _adaln(c_sample, w_ada[l], b_ada[l])
        f1 = (ffn1_norm_pre[l], ffn1_norm_post[l], ffn1_w1[l], ffn1_w3[l], ffn1_w2[l])
        xp = _half_ffn(xp, mp[0], mp[1], mp[2], *f1)
        xs = _half_ffn(xs, ms[0], ms[1], ms[2], *f1)
        up, qp, kp, vp, gcp, gap = _mixer_in(xp, mp[3], mp[4], mix_norm_pre[l], w_in[l])
        us, qs, ks_, vs_, gcs, gas = _mixer_in(xs, ms[3], ms[4], mix_norm_pre[l], w_in[l])
        yconv_p = _dwconv(jnp.pad(up, ((0, 0), (CONV_WIDTH - 1, 0), (0, 0))), dw_kernel[l], dw_bias[l])
        pconv_l.append(up[:, -(CONV_WIDTH - 1):])
        us_ext = jnp.concatenate([state_conv[l].astype(us.dtype), us], axis=1)
        yconv_s = _dwconv(us_ext, dw_kernel[l], dw_bias[l])
        sconv_l.append(us_ext[:, -(CONV_WIDTH - 1):])
        kp_g = [kp[:, :, g] for g in range(N_GROUPS)]
        vp_g = [vp[:, :, g] for g in range(N_GROUPS)]
        att_p = _prompt_attention(qp, kp_g, vp_g, biases)
        ks_all, vs_all, qidx_s = [], [], []
        for g, (w, d) in enumerate(DILATED_GROUPS):
            Lp = min(w, kp_g[g].shape[1])
            pk[g].append(kp_g[g][:, -Lp:]); pv[g].append(vp_g[g][:, -Lp:])
            k_all = jnp.concatenate([cache_k[g][l].astype(ks_.dtype), ks_[:, :, g]], axis=1)
            v_all = jnp.concatenate([cache_v[g][l].astype(vs_.dtype), vs_[:, :, g]], axis=1)
            qidx_s.append(cache_k[g].shape[2] + jnp.arange(xs.shape[1]))
            ks_all.append(k_all); vs_all.append(v_all)
            Ls = min(w, k_all.shape[1])
            sk[g].append(k_all[:, -Ls:]); sv[g].append(v_all[:, -Ls:])
        att_s = _dilated_attend(qs, ks_all, vs_all, qidx_s, biases)
        mo = (conv_ln_g[l], conv_ln_b[l], w_conv_out[l], w_att_out[l], w_out[l])
        xp = _mixer_out(xp, mp[5], mix_norm_post[l], yconv_p, att_p, gcp, gap, *mo)
        xs = _mixer_out(xs, ms[5], mix_norm_post[l], yconv_s, att_s, gcs, gas, *mo)
        f2 = (ffn2_norm_pre[l], ffn2_norm_post[l], ffn2_w1[l], ffn2_w3[l], ffn2_w2[l])
        xp = _half_ffn(xp, mp[6], mp[7], mp[8], *f2)
        xs = _half_ffn(xs, ms[6], ms[7], ms[8], *f2)
    pk128, pk512, pk2048 = [jnp.stack(a) for a in pk]
    pv128, pv512, pv2048 = [jnp.stack(a) for a in pv]
    sk128, sk512, sk2048 = [jnp.stack(a) for a in sk]
    sv128, sv512, sv2048 = [jnp.stack(a) for a in sv]
    pconv = jnp.stack(pconv_l)
    sconv = jnp.stack(sconv_l)
    return (xp, xs, pk128, pv128, pk512, pv512, pk2048, pv2048, pconv,
            sk128, sv128, sk512, sv512, sk2048, sv2048, sconv)
```

```cpp
#include <hip/hip_runtime.h>
#include <cstdio>
#include <cstdint>

#ifndef MK_N_LAUNCHES
#define MK_N_LAUNCHES 1
#endif

constexpr int T = 8192, NS = 128, MTOK = T + NS, MP = 8448;
constexpr int DM = 2048, FF = 5632, CC = 1024, AW = 1536, NMODW = 9 * DM;
constexpr float EPS = 1e-6f;
constexpr float LOG2E = 1.4426950408889634f;
constexpr float QSCALE = 0.08838834764831845f * LOG2E;

#define GAS __attribute__((address_space(1)))
#define LAS __attribute__((address_space(3)))
typedef unsigned short bf16_t;
typedef short bf16x8 __attribute__((ext_vector_type(8)));
typedef short bf16x4 __attribute__((ext_vector_type(4)));
typedef float f32x4 __attribute__((ext_vector_type(4)));
typedef float f32x2 __attribute__((ext_vector_type(2)));
typedef unsigned u32x4 __attribute__((ext_vector_type(4)));
typedef unsigned u32x2 __attribute__((ext_vector_type(2)));
typedef GAS unsigned gu32;

typedef __bf16 bf16v2 __attribute__((ext_vector_type(2)));
__device__ __forceinline__ unsigned cvt_pk_bf16(float lo, float hi) { const f32x2 v = {lo, hi}; return __builtin_bit_cast(unsigned, __builtin_convertvector(v, bf16v2)); }
__device__ __forceinline__ float bf2f(unsigned short h) { return __builtin_bit_cast(float, (unsigned)h << 16); }
__device__ __forceinline__ float sigm(float x) { return __builtin_amdgcn_rcpf(1.0f + __builtin_amdgcn_exp2f(-LOG2E * x)); }
__device__ __forceinline__ float ex2(float x) { return __builtin_amdgcn_exp2f(x); }
__device__ __forceinline__ f32x4 sigm4(const f32x4 v) { return (f32x4){sigm(v[0]), sigm(v[1]), sigm(v[2]), sigm(v[3])}; }
__device__ __forceinline__ float wave_sum(float v) {
#pragma unroll
    for (int o = 1; o < 64; o <<= 1) v += __shfl_xor(v, o);
    return v;
}

constexpr size_t O_Y = 0;
constexpr size_t O_PK0 = O_Y + (size_t)MTOK * DM, O_PV0 = O_PK0 + 128 * 512, O_PK1 = O_PV0 + 128 * 512, O_PV1 = O_PK1 + 512 * 512, O_PK2 = O_PV1 + 512 * 512, O_PV2 = O_PK2 + 2048 * 512;
constexpr size_t O_PCONV = O_PV2 + 2048 * 512;
constexpr size_t O_SK0 = O_PCONV + 30 * 1024, O_SV0 = O_SK0 + 32ull * 128 * 512, O_SK1 = O_SV0 + 32ull * 128 * 512, O_SV1 = O_SK1 + 32ull * 512 * 512, O_SK2 = O_SV1 + 32ull * 512 * 512, O_SV2 = O_SK2 + 32ull * 2048 * 512;
constexpr size_t O_SCONV = O_SV2 + 32ull * 2048 * 512, O_END = O_SCONV + 32ull * 30 * 1024;
static_assert(O_END == 108886016ull, "output size");
__device__ __forceinline__ size_t o_pk(int g) { return g == 0 ? O_PK0 : (g == 1 ? O_PK1 : O_PK2); }
__device__ __forceinline__ size_t o_pv(int g) { return g == 0 ? O_PV0 : (g == 1 ? O_PV1 : O_PV2); }
__device__ __forceinline__ size_t o_sk(int g) { return g == 0 ? O_SK0 : (g == 1 ? O_SK1 : O_SK2); }
__device__ __forceinline__ size_t o_sv(int g) { return g == 0 ? O_SV0 : (g == 1 ? O_SV1 : O_SV2); }

constexpr size_t MiB = 1u << 20;
constexpr size_t WS_CTL = 0, CTL_ZERO_BYTES = 256 * 1024;
constexpr size_t WS_MOD = 1 * MiB;
constexpr size_t WS_W13A = 4 * MiB, WS_W2A = 48 * MiB, WS_WIN = 70 * MiB, WS_WCO = 112 * MiB, WS_WAO = 116 * MiB, WS_WOUT = 118 * MiB, WS_W13B = 126 * MiB, WS_W2B = 170 * MiB;
constexpr size_t WS_A = 192 * MiB;
constexpr size_t WS_XR = 225 * MiB;
constexpr size_t WS_F = 291 * MiB;
constexpr size_t WS_GH = 357 * MiB;
constexpr size_t WS_U = 448 * MiB;
constexpr size_t WS_QN = 481 * MiB, WS_KN = 506 * MiB;
constexpr size_t WS_VT = 531 * MiB;
constexpr size_t WS_SGC = 555 * MiB, WS_SGA = 588 * MiB;
constexpr size_t WS_YA = 621 * MiB;
constexpr int YAW = 1536;
constexpr size_t WS_T1 = 647 * MiB;
constexpr size_t WS_MG = 713 * MiB;
constexpr size_t WS_SL = 746 * MiB;
constexpr size_t WS_XS = 769 * MiB;
constexpr size_t WS_END = 771 * MiB;
static_assert(WS_MOD + 33ull * NMODW * 4 <= WS_W13A && WS_W13A + 11264ull * 2048 * 2 <= WS_W2A && WS_W2A + 2048ull * 5632 * 2 <= WS_WIN && WS_WIN + 10752ull * 2048 * 2 <= WS_WCO, "ws map 1");
static_assert(WS_WCO + 2048ull * 1536 * 2 <= WS_WOUT && WS_WOUT + 2048ull * 2048 * 2 <= WS_W13B && WS_W13B + 11264ull * 2048 * 2 <= WS_W2B && WS_W2B + 2048ull * 5632 * 2 <= WS_A, "ws map 2");
static_assert(WS_A + (size_t)MP * DM * 2 <= WS_XR && WS_XR + (size_t)MP * DM * 4 <= WS_F && WS_F + (size_t)MP * DM * 4 <= WS_GH && WS_GH + (size_t)MP * FF * 2 <= WS_U && WS_U + (size_t)MP * CC * 4 <= WS_QN, "ws map 3");
static_assert(WS_QN + (size_t)MP * AW * 2 <= WS_KN && WS_KN + (size_t)MP * AW * 2 <= WS_VT && WS_VT + (size_t)AW * T * 2 <= WS_SGC && WS_SGC + (size_t)MP * DM * 2 <= WS_SGA && WS_SGA + (size_t)MP * DM * 2 <= WS_YA, "ws map 4");
static_assert(WS_YA + (size_t)MP * YAW * 2 <= WS_T1 && WS_T1 + (size_t)MP * DM * 4 <= WS_MG && WS_MG + (size_t)MP * DM * 2 <= WS_SL && WS_SL + 22ull * 128 * DM * 4 <= WS_XS && WS_XS + 3ull * 2 * 32 * 256 * 8 * 4 <= WS_END, "ws map 5");
constexpr int CW_BAR = 4096;
constexpr int CW_XC = 32768;
static_assert((CW_XC + 3 * 2 * 32 * 64) * 4 <= (int)CTL_ZERO_BYTES, "exchange counters inside the zeroed region");

constexpr int RING_BYTES = 131072, LDSCTL_OFF = RING_BYTES, MISC_OFF = LDSCTL_OFF + 320, LDS_BYTES = 147456;
constexpr int NWAVES = 8;
constexpr int XL_OFF = RING_BYTES + 1024;
static_assert(XL_OFF + 8192 <= LDS_BYTES, "LDS map");

__constant__ unsigned char BKT[3][132] = {
 {0,1,2,3,4,5,6,7,8,9,10,11,12,13,14,15,16,16,16,16,16,16,17,17,17,17,17,17,17,17,18,18,18,18,18,18,18,18,18,18,19,19,19,19,19,19,19,19,19,19,19,19,19,19,20,20,20,20,20,20,20,20,20,20,20,20,20,20,20,20,20,20,20,21,21,21,21,21,21,21,21,21,21,21,21,21,21,21,21,21,21,21,21,21,21,21,21,21,21,22,22,22,22,22,22,22,22,22,22,22,22,22,22,22,22,22,22,22,22,22,22,22,22,22,22,22,22,22,22,0,0,0},
 {0,4,8,12,16,16,17,17,18,18,19,19,19,19,20,20,20,20,20,21,21,21,21,21,21,22,22,22,22,22,22,22,22,22,23,23,23,23,23,23,23,23,23,23,23,23,24,24,24,24,24,24,24,24,24,24,24,24,24,24,24,24,25,25,25,25,25,25,25,25,25,25,25,25,25,25,25,25,25,25,25,25,25,26,26,26,26,26,26,26,26,26,26,26,26,26,26,26,26,26,26,26,26,26,26,26,26,26,26,26,26,26,26,27,27,27,27,27,27,27,27,27,27,27,27,27,27,27,27,0,0,0},
 {0,16,18,19,20,21,21,22,22,23,23,23,24,24,24,24,25,25,25,25,25,26,26,26,26,26,26,26,26,27,27,27,27,27,27,27,27,27,27,28,28,28,28,28,28,28,28,28,28,28,28,28,29,29,29,29,29,29,29,29,29,29,29,29,29,29,29,29,29,29,30,30,30,30,30,30,30,30,30,30,30,30,30,30,30,30,30,30,30,30,30,30,30,30,30,31,31,31,31,31,31,31,31,31,31,31,31,31,31,31,31,31,31,31,31,31,31,31,31,31,31,31,31,31,31,31,31,31,31,0,0,0}};

namespace pg8 {
constexpr int BM = 256, BK = 64, HALF = 128, HTB = HALF * BK * 2, STAGE_BYTES = 8 * HTB, NXCD = 8, WGM = 8;
__host__ __device__ __forceinline__ int lds_byte(int r, int c) { const int st = (r >> 4) * 2 + (c >> 5), rr = r & 15, cc = c & 31, ob = rr * 64 + cc * 2; return st * 1024 + (ob ^ (((ob >> 9) & 1) << 5)); }
__host__ __device__ __forceinline__ void stage_rc(int b, int& R, int& C) { const int st = b / 1024, sb = b % 1024, swz = sb ^ (((sb >> 9) & 1) << 5); R = (st >> 1) * 16 + swz / 64; C = (st & 1) * 32 + (swz % 64) / 2; }
__host__ __device__ __forceinline__ int perm32(int rho) { const int n = rho >> 4, i = rho & 15; return 8 * (i >> 2) + 4 * n + (i & 3); }

struct Unit { int pm, pn, kind, k0t, nt; };

__device__ __forceinline__ void std_order(int L, int nM, int nN, int& pm, int& pn) {
    const int nwg = nM * nN; int wgid = L;
    { const int q = nwg / NXCD, r = nwg % NXCD, xcd = wgid % NXCD, off = wgid / NXCD; wgid = (xcd < r ? xcd * (q + 1) : r * (q + 1) + (xcd - r) * q) + off; }
    const int nig = WGM * nN, gid = wgid / nig, fm = gid * WGM, gsz = (nM - fm) < WGM ? (nM - fm) : WGM;
    pm = fm + ((wgid % nig) % gsz); pn = (wgid % nig) / gsz;
}
struct SimpleSched {
    static constexpr bool VARB = false;
    const char* A; const char* Bt; int nM, nN, nwg, G, c, ntk; size_t tstep;
    __device__ void init(const void* A_, const void* Bt_, int M, int N, int K, int G_, int c_) { A = (const char*)A_; Bt = (const char*)Bt_; nM = M / BM; nN = N / BM; nwg = nM * nN; G = G_; c = c_; ntk = K / BK; tstep = (size_t)BM * K * 2; }
    __device__ __forceinline__ bool next(int i, Unit& u) const { const int L = i * G + c; if (L >= nwg) return false; std_order(L, nM, nN, u.pm, u.pn); u.kind = 0; u.k0t = 0; u.nt = ntk; return true; }
    __device__ __forceinline__ void addr(const Unit& u, const char*& a, const char*& b, int& bmul) const { a = A + (size_t)u.pm * tstep; b = Bt + (size_t)u.pn * tstep; bmul = 1; }
};
struct DownSched {
    static constexpr bool VARB = false;
    const char* A; const char* Bt; int G, c, S, ntp, ntk; size_t tstep;
    __device__ void init(const void* A_, const void* Bt_, int K, int S_, int G_, int c_) { A = (const char*)A_; Bt = (const char*)Bt_; G = G_; c = c_; S = S_; ntk = K / BK; ntp = ntk / S_; tstep = (size_t)BM * K * 2; }
    __device__ __forceinline__ bool next(int i, Unit& u) const {
        const int L = i * G + c;
        if (L < 256) { std_order(L, 32, 8, u.pm, u.pn); u.kind = 0; u.k0t = 0; u.nt = ntk; return true; }
        const int q = L - 256; if (q >= 8 * S) return false;
        u.pm = 32; u.pn = q & 7; const int s = q >> 3; u.kind = 1 + s; u.k0t = s * ntp; u.nt = ntp; return true;
    }
    __device__ __forceinline__ void addr(const Unit& u, const char*& a, const char*& b, int& bmul) const { a = A + (size_t)u.pm * tstep + (size_t)u.k0t * (BK * 2); b = Bt + (size_t)u.pn * tstep + (size_t)u.k0t * (BK * 2); bmul = 1; }
};
struct PairSched {
    static constexpr bool VARB = false;
    const char* A; const char* Bt; int G, c; size_t tstep;
    __device__ void init(const void* A_, const void* Bt_, int G_, int c_) { A = (const char*)A_; Bt = (const char*)Bt_; G = G_; c = c_; tstep = (size_t)BM * YAW * 2; }
    __device__ __forceinline__ bool next(int i, Unit& u) const {
        const int L = (i >> 1) * G + c; if (L >= 33 * 8) return false;
        std_order(L, 33, 8, u.pm, u.pn); u.kind = i & 1; u.k0t = (i & 1) ? 16 : 0; u.nt = (i & 1) ? 8 : 16; return true;
    }
    __device__ __forceinline__ void addr(const Unit& u, const char*& a, const char*& b, int& bmul) const { a = A + (size_t)u.pm * tstep + (size_t)u.k0t * (BK * 2); b = Bt + (size_t)u.pn * tstep + (size_t)u.k0t * (BK * 2); bmul = 1; }
};
struct MixSched {
    static constexpr bool VARB = true;
    const char* A2; const char* WIN; int G, c; size_t tstep;
    static constexpr int N0 = 33 * 36, N1 = N0 + 6, N2 = N1 + 192;
    __device__ void init(const void* A2_, const void* WIN_, int G_, int c_) { A2 = (const char*)A2_; WIN = (const char*)WIN_; G = G_; c = c_; tstep = (size_t)BM * DM * 2; }
    __device__ __forceinline__ bool next(int i, Unit& u) const {
        const int L = i * G + c; if (L >= N2) return false;
        u.k0t = 0; u.nt = DM / BK;
        if (L < N0) { std_order(L, 33, 36, u.pm, u.pn); u.kind = 0; }
        else if (L < N1) { u.pm = 32; u.pn = 36 + (L - N0); u.kind = 0; }
        else { const int idx = L - N1; u.pm = idx % 6; u.pn = idx / 6; u.kind = 1; }
        return true;
    }
    __device__ __forceinline__ void addr(const Unit& u, const char*& a, const char*& b, int& bmul) const {
        if (u.kind == 0) { a = A2 + (size_t)u.pm * tstep; b = WIN + (size_t)u.pn * tstep; bmul = 1; }
        else { const int g = u.pm >> 1, sh = 2 * g, seg = T >> sh, p0 = u.pn * BM, rr = p0 / seg, j0 = p0 % seg;
               a = WIN + (size_t)(36 + u.pm) * tstep; b = A2 + (size_t)(rr + (j0 << sh)) * (DM * 2); bmul = 1 << sh; }
    }
};

template <class Epi, class Sched>
__device__ __forceinline__ void gemm_phase(LAS unsigned char* lds, const int K, const Sched& S, const Epi& E) {
    const int tid = threadIdx.x, wid = __builtin_amdgcn_readfirstlane(tid >> 6), lane = tid & 63, wr = wid >> 2, wc = wid & 3, fr = lane & 15, fq = lane >> 4;
    unsigned voffA[2], rbk[2], c2[2];
#pragma unroll
    for (int i = 0; i < 2; ++i) { int R, C; stage_rc(tid * 16 + i * 8192, R, C); const int Rb = Epi::PERM ? ((R & ~31) + perm32(R & 31)) : R;
        voffA[i] = (unsigned)(R * K + C) * 2u; rbk[i] = (unsigned)(Rb * K) * 2u; c2[i] = (unsigned)C * 2u; }
    const size_t kstep = (size_t)(BK * 2);
    const size_t hstep = (size_t)HALF * K * 2;
    const unsigned ldsw = (unsigned)wid * 1024u;
    const int aoff = lds_byte(wr * 64 + fr, fq * 8), boff = lds_byte(wc * 32 + fr, fq * 8);
#define PG8_SA(b, h) (((b) * 2 + (h)) * HTB)
#define PG8_SB(b, h) ((4 + (b) * 2 + (h)) * HTB)
#define PG8_STAGE(bufoff, gbase, voff) do { _Pragma("unroll") for (int _i = 0; _i < 2; ++_i) \
        __builtin_amdgcn_global_load_lds((const unsigned*)((const char*)(gbase) + (voff)[_i]), (LAS unsigned*)(lds + (bufoff) + ldsw + _i * 8192), 16, 0, 0); } while (0)
#define PG8_LDA(dst, b, h) do { _Pragma("unroll") for (int m = 0; m < 4; ++m) _Pragma("unroll") for (int k = 0; k < 2; ++k) dst[m][k] = *(const LAS bf16x8*)(lds + PG8_SA(b, h) + aoff + m * 2048 + k * 1024); } while (0)
#define PG8_LDB(dst, b, h) do { _Pragma("unroll") for (int n = 0; n < 2; ++n) _Pragma("unroll") for (int k = 0; k < 2; ++k) dst[n][k] = *(const LAS bf16x8*)(lds + PG8_SB(b, h) + boff + n * 2048 + k * 1024); } while (0)
#define PG8_MMA(ai, bj, At, Bt) do { __builtin_amdgcn_s_setprio(1); _Pragma("unroll") for (int m = 0; m < 4; ++m) _Pragma("unroll") for (int n = 0; n < 2; ++n) _Pragma("unroll") for (int k = 0; k < 2; ++k) \
        acc[ai][bj][m][n] = __builtin_amdgcn_mfma_f32_16x16x32_bf16(Bt[n][k], At[m][k], acc[ai][bj][m][n], 0, 0, 0); __builtin_amdgcn_s_setprio(0); } while (0)
#define PG8_WAIT_V(n) asm volatile("s_waitcnt vmcnt(" #n ")" ::: "memory")
#define PG8_WAIT_L(n) asm volatile("s_waitcnt lgkmcnt(" #n ")" ::: "memory")
#define PG8_BAR __builtin_amdgcn_s_barrier()
#define PG8_SCHED __builtin_amdgcn_sched_barrier(0)
    Unit cur, nxt; int ui = 0;
    if (!S.next(0, cur)) return;
    f32x4 acc[2][2][4][2];
#pragma unroll
    for (int a = 0; a < 2; ++a)
#pragma unroll
        for (int b = 0; b < 2; ++b)
#pragma unroll
            for (int m = 0; m < 4; ++m)
#pragma unroll
                for (int n = 0; n < 2; ++n) acc[a][b][m][n] = (f32x4){0.f, 0.f, 0.f, 0.f};
    bf16x8 At[4][2], B0[2][2], B1[2][2];
    const char* cA; const char* cB; int cmul; S.addr(cur, cA, cB, cmul);
    unsigned cvB[2] = {rbk[0] * (unsigned)cmul + c2[0], rbk[1] * (unsigned)cmul + c2[1]}; size_t chB = hstep * (size_t)cmul;
    PG8_STAGE(PG8_SB(0, 0), cB, cvB); PG8_STAGE(PG8_SB(0, 1), cB + chB, cvB); PG8_STAGE(PG8_SA(0, 0), cA, voffA); PG8_STAGE(PG8_SA(0, 1), cA + hstep, voffA);
    if (wr == 1) PG8_BAR;
    PG8_WAIT_V(2); PG8_BAR;
    PG8_STAGE(PG8_SB(1, 0), cB + kstep, cvB); PG8_STAGE(PG8_SA(1, 0), cA + kstep, voffA); PG8_STAGE(PG8_SB(1, 1), cB + chB + kstep, cvB);
    PG8_WAIT_V(6); PG8_BAR;
    for (;;) {
        const bool has_next = S.next(ui + 1, nxt);
        const char* nA = cA; const char* nB = cB; int nmul = cmul;
        if (has_next) S.addr(nxt, nA, nB, nmul);
        unsigned nvB[2] = {rbk[0] * (unsigned)nmul + c2[0], rbk[1] * (unsigned)nmul + c2[1]}; const size_t nhB = hstep * (size_t)nmul;
        const int nt = cur.nt;
        for (int t = 0; t < nt; t += 2) {
            const bool last = (t == nt - 2);
            const char* a1 = cA + (size_t)(t + 1) * kstep;
            const char* a2 = last ? nA : cA + (size_t)(t + 2) * kstep; const char* b2 = last ? nB : cB + (size_t)(t + 2) * kstep;
            const char* a3 = a2 + kstep; const char* b3 = b2 + kstep;
            unsigned vb[2]; size_t hB;
            if constexpr (Sched::VARB) { vb[0] = last ? nvB[0] : cvB[0]; vb[1] = last ? nvB[1] : cvB[1]; hB = last ? nhB : chB; } else { vb[0] = cvB[0]; vb[1] = cvB[1]; hB = hstep; }
            PG8_LDB(B0, 0, 0); PG8_LDB(B1, 0, 1); PG8_SCHED; PG8_LDA(At, 0, 0); PG8_STAGE(PG8_SA(1, 1), a1 + hstep, voffA);
            PG8_WAIT_V(8); PG8_WAIT_L(0); PG8_BAR; PG8_MMA(0, 0, At, B0); PG8_MMA(0, 1, At, B1); PG8_BAR; PG8_SCHED;
            PG8_LDA(At, 0, 1); PG8_STAGE(PG8_SB(0, 0), b2, vb); PG8_STAGE(PG8_SB(0, 1), b2 + hB, vb); PG8_STAGE(PG8_SA(0, 0), a2, voffA);
            PG8_WAIT_V(8); PG8_WAIT_L(0); PG8_BAR; PG8_MMA(1, 0, At, B0); PG8_MMA(1, 1, At, B1); PG8_BAR; PG8_SCHED;
            PG8_LDB(B0, 1, 0); PG8_LDB(B1, 1, 1); PG8_SCHED; PG8_LDA(At, 1, 0); PG8_STAGE(PG8_SA(0, 1), a2 + hstep, voffA);
            PG8_WAIT_V(8); PG8_WAIT_L(0); PG8_BAR; PG8_MMA(0, 0, At, B0); PG8_MMA(0, 1, At, B1); PG8_BAR; PG8_SCHED;
            PG8_LDA(At, 1, 1); PG8_STAGE(PG8_SB(1, 0), b3, vb); PG8_STAGE(PG8_SB(1, 1), b3 + hB, vb); PG8_STAGE(PG8_SA(1, 0), a3, voffA);
            PG8_WAIT_V(8); PG8_WAIT_L(0); PG8_BAR; PG8_MMA(1, 0, At, B0); PG8_MMA(1, 1, At, B1); PG8_BAR; PG8_SCHED;
        }
        if (wr == 0) PG8_BAR;
        E(acc, cur, wr, wc, fr, fq);
        if (!has_next) break;
        if (!E.keep(cur))
#pragma unroll
        for (int a = 0; a < 2; ++a)
#pragma unroll
            for (int b = 0; b < 2; ++b)
#pragma unroll
                for (int m = 0; m < 4; ++m)
#pragma unroll
                    for (int n = 0; n < 2; ++n) acc[a][b][m][n] = (f32x4){0.f, 0.f, 0.f, 0.f};
        cur = nxt; cA = nA; cB = nB; cmul = nmul; cvB[0] = nvB[0]; cvB[1] = nvB[1]; chB = nhB; ++ui;
        if (wr == 1) PG8_BAR;
    }
    PG8_WAIT_V(0);
    PG8_BAR;
#undef PG8_SA
#undef PG8_SB
#undef PG8_STAGE
#undef PG8_LDA
#undef PG8_LDB
#undef PG8_MMA
#undef PG8_WAIT_V
#undef PG8_WAIT_L
#undef PG8_BAR
#undef PG8_SCHED
}

typedef f32x4 Acc[2][2][4][2];
__device__ __forceinline__ u32x4 pack8(const f32x4 v0, const f32x4 v1) { u32x4 w; w.x = cvt_pk_bf16(v0[0], v0[1]); w.y = cvt_pk_bf16(v0[2], v0[3]); w.z = cvt_pk_bf16(v1[0], v1[1]); w.w = cvt_pk_bf16(v1[2], v1[3]); return w; }

struct EpiSwiglu {
    __device__ __forceinline__ bool keep(const Unit&) const { return false; }
    static constexpr bool PERM = true;
    bf16_t* G;
    __device__ __forceinline__ void operator()(const Acc& acc, const Unit& u, int wr, int wc, int fr, int fq) const {
        const int row0 = u.pm * BM + wr * 64 + fr, col0 = u.pn * HALF + wc * 32 + 8 * fq;
#pragma unroll
        for (int ai = 0; ai < 2; ++ai)
#pragma unroll
            for (int m = 0; m < 4; ++m) {
                const f32x4 a0 = acc[ai][0][m][0], a1 = acc[ai][0][m][1], b0 = acc[ai][1][m][0], b1 = acc[ai][1][m][1];
                const f32x4 g0 = a0 * sigm4(a0) * b0, g1 = a1 * sigm4(a1) * b1;
                *(u32x4*)(G + (size_t)(row0 + ai * HALF + m * 16) * FF + col0) = pack8(g0, g1);
            }
    }
};
struct EpiF32 {
    __device__ __forceinline__ bool keep(const Unit&) const { return false; }
    static constexpr bool PERM = false;
    float* C; float* SL;
    __device__ __forceinline__ void operator()(const Acc& acc, const Unit& u, int wr, int wc, int fr, int fq) const {
        const int col0 = u.pn * BM + wc * 32 + 4 * fq;
        if (u.kind == 0) {
            const int row0 = u.pm * BM + wr * 64 + fr;
#pragma unroll
            for (int ai = 0; ai < 2; ++ai)
#pragma unroll
                for (int m = 0; m < 4; ++m) { float* rowp = C + (size_t)(row0 + ai * HALF + m * 16) * DM + col0;
#pragma unroll
                    for (int bj = 0; bj < 2; ++bj)
#pragma unroll
                        for (int n = 0; n < 2; ++n) *(f32x4*)(rowp + bj * HALF + n * 16) = acc[ai][bj][m][n]; }
        } else {
            float* sl = SL + (size_t)(u.kind - 1) * 128 * DM;
#pragma unroll
            for (int m = 0; m < 4; ++m) { float* rowp = sl + (size_t)(wr * 64 + m * 16 + fr) * DM + col0;
#pragma unroll
                for (int bj = 0; bj < 2; ++bj)
#pragma unroll
                    for (int n = 0; n < 2; ++n) *(f32x4*)(rowp + bj * HALF + n * 16) = acc[0][bj][m][n]; }
        }
    }
};
template <int MODE>
struct EpiDownFused {
    __device__ __forceinline__ bool keep(const Unit&) const { return false; }
    static constexpr bool PERM = true;
    static constexpr int gate_i = (MODE == 1) ? 2 : (MODE == 2 ? 5 : 8), shift_i = (MODE == 1) ? 3 : 6, scale_i = (MODE == 1) ? 4 : 7;
    static constexpr float gsc = (MODE == 2) ? 1.0f : 0.5f;
    float* SL; const float* xin; bf16_t* XR; bf16_t* A; float* out; const float* mod; const float* npost; const float* npre;
    float* xs; unsigned* cnt; LAS unsigned char* xl;
    __device__ __forceinline__ void stats(const Acc& acc, int e, const int upm, const int upn, int wr, int wc, int fr, int fq) const {
        LAS float* P = (LAS float*)xl; LAS float* S = P + 1024; const int tid = threadIdx.x, wid = __builtin_amdgcn_readfirstlane(tid >> 6);
#pragma unroll
        for (int ai = 0; ai < 2; ++ai)
#pragma unroll
            for (int m = 0; m < 4; ++m) { float s = 0.f;
#pragma unroll
                for (int bj = 0; bj < 2; ++bj)
#pragma unroll
                    for (int n = 0; n < 2; ++n) { const f32x4 v = acc[ai][bj][m][n]; s += (v[0] * v[0] + v[1] * v[1]) + (v[2] * v[2] + v[3] * v[3]); }
                s += __shfl_xor(s, 16); s += __shfl_xor(s, 32);
                if (fq == 0) P[(ai * HALF + wr * 64 + m * 16 + fr) * 4 + wc] = s; }
        asm volatile("s_waitcnt lgkmcnt(0)" ::: "memory"); __builtin_amdgcn_s_barrier(); asm volatile("" ::: "memory");
        float* slot = xs + ((size_t)(e * 32 + upm) * 256) * 8; unsigned* c = cnt + (e * 32 + upm) * 64;
        if (tid < 256) { const f32x4 p = *(const LAS f32x4*)(P + tid * 4); __hip_atomic_store(slot + tid * 8 + upn, (p[0] + p[1]) + (p[2] + p[3]), __ATOMIC_RELAXED, __HIP_MEMORY_SCOPE_AGENT); }
        asm volatile("s_waitcnt vmcnt(0)" ::: "memory");
        if (tid < 256 && (tid & 63) == 0) __hip_atomic_fetch_add(c, 1u, __ATOMIC_RELAXED, __HIP_MEMORY_SCOPE_AGENT);
        if (wid == 0) {
            unsigned sp = 0;
            while ((unsigned)__builtin_amdgcn_readfirstlane(__hip_atomic_load(c, __ATOMIC_RELAXED, __HIP_MEMORY_SCOPE_AGENT)) < 32u) { __builtin_amdgcn_s_sleep(2); if (++sp > (1u << 22)) break; }
            __builtin_amdgcn_fence(__ATOMIC_ACQUIRE, "agent");
            asm volatile("s_waitcnt vmcnt(0)" ::: "memory");
        }
        asm volatile("s_waitcnt lgkmcnt(0)" ::: "memory"); __builtin_amdgcn_s_barrier(); asm volatile("" ::: "memory");
        if (tid < 256) { const f32x4 a0 = *(const f32x4*)(slot + tid * 8), a1 = *(const f32x4*)(slot + tid * 8 + 4);
            S[tid] = __builtin_amdgcn_rsqf(((a0[0] + a0[1]) + (a0[2] + a0[3]) + (a1[0] + a1[1]) + (a1[2] + a1[3])) * (1.0f / DM) + EPS); }
        asm volatile("s_waitcnt lgkmcnt(0)" ::: "memory"); __builtin_amdgcn_s_barrier(); asm volatile("" ::: "memory");
    }
    __device__ __forceinline__ void operator()(Acc& acc, const Unit& u, int wr, int wc, int fr, int fq) const {
        const int col0 = u.pn * BM + wc * 32 + 8 * fq;
        if (u.kind != 0) {
            int fr_ = fr; asm volatile("" : "+v"(fr_));
            float* sl = SL + (size_t)(u.kind - 1) * 128 * DM;
#pragma unroll
            for (int m = 0; m < 4; ++m) { float* rowp = sl + (size_t)(wr * 64 + m * 16 + fr_) * DM + col0;
#pragma unroll
                for (int bj = 0; bj < 2; ++bj)
#pragma unroll
                    for (int n = 0; n < 2; ++n) *(f32x4*)(rowp + bj * HALF + n * 4) = acc[0][bj][m][n]; }
            return;
        }
        const LAS float* S = (const LAS float*)xl + 1024;
        const int rl0 = wr * 64 + fr;
        constexpr int NPRE = (MODE == 3) ? 2 : 1;
        u32x4 pre[2][4][2];
        if (MODE != 1) {
#pragma unroll
            for (int ai = 0; ai < NPRE; ++ai)
#pragma unroll
                for (int m = 0; m < 4; ++m)
#pragma unroll
                    for (int bj = 0; bj < 2; ++bj) pre[ai][m][bj] = *(const u32x4*)(XR + (size_t)(u.pm * BM + rl0 + ai * HALF + m * 16) * DM + col0 + bj * HALF);
        }
        stats(acc, 0, u.pm, u.pn, wr, wc, fr, fq);
#pragma unroll
        for (int ai = 0; ai < 2; ++ai)
#pragma unroll
            for (int m = 0; m < 4; ++m) { const int rl = rl0 + ai * HALF + m * 16; const size_t ro = (size_t)(u.pm * BM + rl) * DM; const float rinv = S[rl];
#pragma unroll
                for (int bj = 0; bj < 2; ++bj) { const int c0 = col0 + bj * HALF;
                    f32x4 xo[2];
                    if (MODE == 1) { xo[0] = *(const f32x4*)(xin + ro + c0); xo[1] = *(const f32x4*)(xin + ro + c0 + 4); }
                    else { const u32x4 w = (ai < NPRE) ? pre[ai][m][bj] : *(const u32x4*)(XR + ro + c0);
                        xo[0] = (f32x4){__builtin_bit_cast(float, w.x << 16), __builtin_bit_cast(float, w.x & 0xffff0000u), __builtin_bit_cast(float, w.y << 16), __builtin_bit_cast(float, w.y & 0xffff0000u)};
                        xo[1] = (f32x4){__builtin_bit_cast(float, w.z << 16), __builtin_bit_cast(float, w.z & 0xffff0000u), __builtin_bit_cast(float, w.w << 16), __builtin_bit_cast(float, w.w & 0xffff0000u)}; }
#pragma unroll
                    for (int n = 0; n < 2; ++n) { const int c = c0 + n * 4;
                        const f32x4 gtv = *(const f32x4*)(mod + gate_i * DM + c) * gsc, npv = *(const f32x4*)(npost + c);
                        const f32x4 v = xo[n] + gtv * (acc[ai][bj][m][n] * rinv * npv);
                        acc[ai][bj][m][n] = v;
                        if (MODE == 3) *(f32x4*)(out + O_Y + ro + c) = v; }
                    if (MODE != 3) *(u32x4*)(XR + ro + c0) = pack8(acc[ai][bj][m][0], acc[ai][bj][m][1]); }
                if (m & 1) __builtin_amdgcn_sched_barrier(0); }
        if (MODE == 3) return;
        f32x4 npr[2][2], sc1[2][2], sh[2][2];
#pragma unroll
        for (int bj = 0; bj < 2; ++bj)
#pragma unroll
            for (int n = 0; n < 2; ++n) { const int c = col0 + bj * HALF + n * 4; npr[bj][n] = *(const f32x4*)(npre + c); sc1[bj][n] = *(const f32x4*)(mod + scale_i * DM + c) + 1.0f; sh[bj][n] = *(const f32x4*)(mod + shift_i * DM + c); }
        stats(acc, 1, u.pm, u.pn, wr, wc, fr, fq);
#pragma unroll
        for (int ai = 0; ai < 2; ++ai)
#pragma unroll
            for (int m = 0; m < 4; ++m) { const int rl = rl0 + ai * HALF + m * 16; const size_t ro = (size_t)(u.pm * BM + rl) * DM; const float rinv = S[rl];
#pragma unroll
                for (int bj = 0; bj < 2; ++bj)
#pragma unroll
                    for (int n = 0; n < 2; ++n) { const int c = col0 + bj * HALF + n * 4;
                        const f32x4 h = (acc[ai][bj][m][n] * rinv * npr[bj][n]) * sc1[bj][n] + sh[bj][n];
                        *(u32x2*)(A + ro + c) = (u32x2){cvt_pk_bf16(h[0], h[1]), cvt_pk_bf16(h[2], h[3])}; } }
    }
};
struct EpiMixA {
    __device__ __forceinline__ bool keep(const Unit&) const { return false; }
    static constexpr bool PERM = true;
    float* T1; const bf16_t* SGC;
    __device__ __forceinline__ void operator()(const Acc& acc, const Unit& u, int wr, int wc, int fr, int fq) const {
        const int row0 = u.pm * BM + wr * 64 + fr, col0 = u.pn * BM + wc * 32 + 8 * fq;
#pragma unroll
        for (int ai = 0; ai < 2; ++ai)
#pragma unroll
            for (int m = 0; m < 4; ++m)
#pragma unroll
                for (int bj = 0; bj < 2; ++bj) { const size_t off = (size_t)(row0 + ai * HALF + m * 16) * DM + col0 + bj * HALF;
                    const u32x4 s = *(const u32x4*)(SGC + off);
                    f32x4 g0 = {__builtin_bit_cast(float, s.x << 16), __builtin_bit_cast(float, s.x & 0xffff0000u), __builtin_bit_cast(float, s.y << 16), __builtin_bit_cast(float, s.y & 0xffff0000u)};
                    f32x4 g1 = {__builtin_bit_cast(float, s.z << 16), __builtin_bit_cast(float, s.z & 0xffff0000u), __builtin_bit_cast(float, s.w << 16), __builtin_bit_cast(float, s.w & 0xffff0000u)};
                    *(f32x4*)(T1 + off) = acc[ai][bj][m][0] * g0; *(f32x4*)(T1 + off + 4) = acc[ai][bj][m][1] * g1; }
    }
};
struct EpiMixB {
    __device__ __forceinline__ bool keep(const Unit&) const { return false; }
    static constexpr bool PERM = true;
    const float* T1; const bf16_t* SGA; bf16_t* MG;
    __device__ __forceinline__ void operator()(const Acc& acc, const Unit& u, int wr, int wc, int fr, int fq) const {
        const int row0 = u.pm * BM + wr * 64 + fr, col0 = u.pn * BM + wc * 32 + 8 * fq;
#pragma unroll
        for (int ai = 0; ai < 2; ++ai)
#pragma unroll
            for (int m = 0; m < 4; ++m)
#pragma unroll
                for (int bj = 0; bj < 2; ++bj) { const size_t off = (size_t)(row0 + ai * HALF + m * 16) * DM + col0 + bj * HALF;
                    const u32x4 s = *(const u32x4*)(SGA + off);
                    f32x4 g0 = {__builtin_bit_cast(float, s.x << 16), __builtin_bit_cast(float, s.x & 0xffff0000u), __builtin_bit_cast(float, s.y << 16), __builtin_bit_cast(float, s.y & 0xffff0000u)};
                    f32x4 g1 = {__builtin_bit_cast(float, s.z << 16), __builtin_bit_cast(float, s.z & 0xffff0000u), __builtin_bit_cast(float, s.w << 16), __builtin_bit_cast(float, s.w & 0xffff0000u)};
                    const f32x4 t0 = *(const f32x4*)(T1 + off), t1 = *(const f32x4*)(T1 + off + 4);
                    *(u32x4*)(MG + off) = pack8(t0 + acc[ai][bj][m][0] * g0, t1 + acc[ai][bj][m][1] * g1); }
    }
};
struct EpiMixPair {
    static constexpr bool PERM = true;
    const bf16_t* RT; const bf16_t* SGA; bf16_t* MG;
    __device__ __forceinline__ bool keep(const Unit& u) const { return u.kind == 0; }
    __device__ __forceinline__ void operator()(Acc& acc, const Unit& u, int wr, int wc, int fr, int fq) const {
        const int row0 = u.pm * BM + wr * 64 + fr, col0 = u.pn * BM + wc * 32 + 8 * fq;
        const bf16_t* G = (u.kind == 0) ? RT : SGA;
        u32x4 s[2][4][2];
#pragma unroll
        for (int ai = 0; ai < 2; ++ai)
#pragma unroll
            for (int m = 0; m < 4; ++m)
#pragma unroll
                for (int bj = 0; bj < 2; ++bj) s[ai][m][bj] = *(const u32x4*)(G + (size_t)(row0 + ai * HALF + m * 16) * DM + col0 + bj * HALF);
#pragma unroll
        for (int ai = 0; ai < 2; ++ai)
#pragma unroll
            for (int m = 0; m < 4; ++m)
#pragma unroll
                for (int bj = 0; bj < 2; ++bj) { const u32x4 w = s[ai][m][bj];
                    const f32x4 g0 = {__builtin_bit_cast(float, w.x << 16), __builtin_bit_cast(float, w.x & 0xffff0000u), __builtin_bit_cast(float, w.y << 16), __builtin_bit_cast(float, w.y & 0xffff0000u)};
                    const f32x4 g1 = {__builtin_bit_cast(float, w.z << 16), __builtin_bit_cast(float, w.z & 0xffff0000u), __builtin_bit_cast(float, w.w << 16), __builtin_bit_cast(float, w.w & 0xffff0000u)};
                    acc[ai][bj][m][0] *= g0; acc[ai][bj][m][1] *= g1;
                    if (u.kind == 1) *(u32x4*)(MG + (size_t)(row0 + ai * HALF + m * 16) * DM + col0 + bj * HALF) = pack8(acc[ai][bj][m][0], acc[ai][bj][m][1]); }
    }
};
struct EpiMixIn {
    __device__ __forceinline__ bool keep(const Unit&) const { return false; }
    static constexpr bool PERM = true;
    bf16_t* U; bf16_t* QN; bf16_t* KN; bf16_t* VT; bf16_t* SGC; bf16_t* SGA; float* out;
    __device__ __forceinline__ void operator()(const Acc& acc, const Unit& u, int wr, int wc, int fr, int fq) const {
        const int rbase = u.pm * BM + wr * 64 + fr, cin = wc * 32 + 8 * fq;
        if (u.kind == 1) {
            const int g = u.pm >> 1, sh = 2 * g, seg = T >> sh, W = 128 << sh;
            const int p0 = u.pn * BM, rr = p0 / seg, j0 = p0 % seg;
            const bool has_pv = (rr + ((j0 + 255) << sh)) >= T - W;
            float* pv = out + o_pv(g);
#pragma unroll
            for (int ai = 0; ai < 2; ++ai)
#pragma unroll
                for (int m = 0; m < 4; ++m) { const int vc = rbase + ai * HALF + m * 16;
#pragma unroll
                    for (int bj = 0; bj < 2; ++bj) { const int pl = bj * HALF + cin;
                        {
                            const int hh = (vc >> 7) & 3, dt = (vc & 127) >> 4, tt = ((j0 + pl) >> 4), kg = 2 * (fq & 1);
                            bf16_t* vb = VT + (size_t)(g * 4 + hh) * (T * 128) + ((size_t)((rr * (seg >> 4) + tt) * 8 + dt)) * 256 + (vc & 15) * 4;
                            *(u32x2*)(vb + (kg * 16) * 4) = (u32x2){cvt_pk_bf16(acc[ai][bj][m][0][0], acc[ai][bj][m][0][1]), cvt_pk_bf16(acc[ai][bj][m][0][2], acc[ai][bj][m][0][3])};
                            *(u32x2*)(vb + ((kg + 1) * 16) * 4) = (u32x2){cvt_pk_bf16(acc[ai][bj][m][1][0], acc[ai][bj][m][1][1]), cvt_pk_bf16(acc[ai][bj][m][1][2], acc[ai][bj][m][1][3])}; }
                        if (has_pv) {
#pragma unroll
                            for (int n = 0; n < 2; ++n)
#pragma unroll
                                for (int i = 0; i < 4; ++i) { const int t = rr + ((j0 + pl + 4 * n + i) << sh);
                                    if (t >= T - W) pv[(size_t)(t - (T - W)) * 512 + (vc & 511)] = acc[ai][bj][m][n][i]; }
                        } } }
            return;
        }
        const int pn = u.pn;
        if (pn < 8) {
            const int col = pn * HALF + cin;
#pragma unroll
            for (int ai = 0; ai < 2; ++ai)
#pragma unroll
                for (int m = 0; m < 4; ++m) { const int r = rbase + ai * HALF + m * 16;
                    const f32x4 u0 = acc[ai][0][m][0] * sigm4(acc[ai][1][m][0]), u1 = acc[ai][0][m][1] * sigm4(acc[ai][1][m][1]);
                    *(u32x4*)(U + (size_t)r * CC + col) = pack8(u0, u1);
                    if (r >= T - 30 && r < T) { float* o = out + O_PCONV + (size_t)(r - (T - 30)) * CC + col; *(f32x4*)o = u0; *(f32x4*)(o + 4) = u1; }
                    else if (r >= T && r < MTOK) { const int b = (r - T) >> 2, j = (r - T) & 3; float* o = out + O_SCONV + (size_t)(b * 30 + 26 + j) * CC + col; *(f32x4*)o = u0; *(f32x4*)(o + 4) = u1; } }
        } else if (pn < 14) {
            const int col = (pn - 8) * BM + cin;
#pragma unroll
            for (int ai = 0; ai < 2; ++ai)
#pragma unroll
                for (int m = 0; m < 4; ++m) { const int r = rbase + ai * HALF + m * 16;
#pragma unroll
                    for (int bj = 0; bj < 2; ++bj) *(u32x4*)(QN + (size_t)r * AW + col + bj * HALF) = pack8(acc[ai][bj][m][0] * QSCALE, acc[ai][bj][m][1] * QSCALE); }
        } else if (pn < 20) {
            const int ct = pn - 14, g = ct >> 1, sh = 2 * g, W = 128 << sh, col = ct * BM + cin;
            float* pk = out + o_pk(g); float* sk = out + o_sk(g);
#pragma unroll
            for (int ai = 0; ai < 2; ++ai)
#pragma unroll
                for (int m = 0; m < 4; ++m) { const int r = rbase + ai * HALF + m * 16;
#pragma unroll
                    for (int bj = 0; bj < 2; ++bj) { const int hc = (ct & 1) * BM + bj * HALF + cin;
                        if (r < T) { const int rr = r & ((1 << sh) - 1), jj = r >> sh, hh = 2 * (ct & 1) + bj;
                            *(u32x4*)(KN + (size_t)(g * 4 + hh) * (T * 128) + ((size_t)((rr * ((T >> sh) >> 4) + (jj >> 4)) * 4 + wc)) * 512 + (fq * 16 + (jj & 15)) * 8) = pack8(acc[ai][bj][m][0], acc[ai][bj][m][1]); }
                        if (r < T) { if (r >= T - W) { float* o = pk + (size_t)(r - (T - W)) * 512 + hc; *(f32x4*)o = acc[ai][bj][m][0]; *(f32x4*)(o + 4) = acc[ai][bj][m][1]; } }
                        else if (r < MTOK) { const int b = (r - T) >> 2, j = (r - T) & 3; float* o = sk + ((size_t)b * W + (W - 4 + j)) * 512 + hc; *(f32x4*)o = acc[ai][bj][m][0]; *(f32x4*)(o + 4) = acc[ai][bj][m][1]; } } }
        } else if (pn < 36) {
            const int col = (pn - 20) * HALF + cin;
#pragma unroll
            for (int ai = 0; ai < 2; ++ai)
#pragma unroll
                for (int m = 0; m < 4; ++m) { const size_t off = (size_t)(rbase + ai * HALF + m * 16) * DM + col;
                    const f32x4 a0 = sigm4(acc[ai][1][m][0]), a1 = sigm4(acc[ai][1][m][1]);
                    const f32x4 e0 = {ex2(-LOG2E * acc[ai][1][m][0][0]), ex2(-LOG2E * acc[ai][1][m][0][1]), ex2(-LOG2E * acc[ai][1][m][0][2]), ex2(-LOG2E * acc[ai][1][m][0][3])};
                    const f32x4 e1 = {ex2(-LOG2E * acc[ai][1][m][1][0]), ex2(-LOG2E * acc[ai][1][m][1][1]), ex2(-LOG2E * acc[ai][1][m][1][2]), ex2(-LOG2E * acc[ai][1][m][1][3])};
                    *(u32x4*)(SGC + off) = pack8(sigm4(acc[ai][0][m][0]) * (e0 + 1.0f), sigm4(acc[ai][0][m][1]) * (e1 + 1.0f));
                    *(u32x4*)(SGA + off) = pack8(a0, a1); }
        } else {
            const int ct = pn - 36, g = ct >> 1, sh = 2 * g, W = 128 << sh;
            float* sv = out + o_sv(g);
#pragma unroll
            for (int ai = 0; ai < 2; ++ai)
#pragma unroll
                for (int m = 0; m < 4; ++m) { const int r = rbase + ai * HALF + m * 16;
                    if (r >= T && r < MTOK) { const int b = (r - T) >> 2, j = (r - T) & 3;
#pragma unroll
                        for (int bj = 0; bj < 2; ++bj) { const int hc = (ct & 1) * BM + bj * HALF + cin; float* o = sv + ((size_t)b * W + (W - 4 + j)) * 512 + hc; *(f32x4*)o = acc[ai][bj][m][0]; *(f32x4*)(o + 4) = acc[ai][bj][m][1]; } } }
        }
    }
};
}

#define RLX_AGENT __ATOMIC_RELAXED, __HIP_MEMORY_SCOPE_AGENT
#define XB_TMO      128
#define XB_XCNT(j)  (256  + 64 * (j))
#define XB_XSUB(j)  (1280 + 64 * (j))
#define XB_XGEN(j)  (2304 + 64 * (j))
#define XB_TOP      3328
#define XB_TOPGEN   3392
#define XCD_BAR_WORDS 3456
#define XB_SPIN_CAP (1u << 18)
__device__ __forceinline__ unsigned xb_ld(unsigned* p)              { return __hip_atomic_load(p, __ATOMIC_RELAXED, __HIP_MEMORY_SCOPE_AGENT); }
__device__ __forceinline__ unsigned xb_add(unsigned* p, unsigned v) { return __hip_atomic_fetch_add(p, v, __ATOMIC_RELAXED, __HIP_MEMORY_SCOPE_AGENT); }
__device__ __forceinline__ unsigned xb_xcc_id() { return (unsigned)__builtin_amdgcn_s_getreg((3 << 11) | 20) & 0xFu; }
#define XB_SPIN(cond, bar) do { unsigned _sp = 0; while (cond) { __builtin_amdgcn_s_sleep(1); \
    if ((++_sp & 255u) == 0u) { if (xb_ld(&(bar)[XB_TMO])) break; if (_sp > XB_SPIN_CAP) { atomicAdd(&(bar)[XB_TMO], 1u); break; } } } } while (0)
struct XcdBarrier { unsigned* bar; unsigned x; volatile LAS unsigned* st; };
__device__ __forceinline__ XcdBarrier xcd_barrier_post(unsigned* bar, volatile LAS unsigned* st) {
    XcdBarrier b; b.bar = bar; b.x = xb_xcc_id(); b.st = st;
    if (threadIdx.x == 0) (void)xb_add(&bar[XB_XCNT(b.x)], 1u);
    return b;
}
__device__ __forceinline__ void xcd_barrier_complete(unsigned* bar, unsigned x, unsigned& nloc, unsigned& nx) {
    const unsigned G = gridDim.x * gridDim.y * gridDim.z;
    unsigned sum, cnt, mine, sp = 0u;
    for (;;) {
        sum = 0u; cnt = 0u; mine = 0u;
#pragma unroll
        for (unsigned j = 0; j < 16; ++j) { const unsigned c = xb_ld(&bar[XB_XCNT(j)]); sum += c; cnt += (c > 0u) ? 1u : 0u; mine = (j == x) ? c : mine; }
        if (sum == G) break;
        __builtin_amdgcn_s_sleep(1);
        if ((++sp & 255u) == 0u) { if (xb_ld(&bar[XB_TMO])) break; if (sp > XB_SPIN_CAP) { atomicAdd(&bar[XB_TMO], 1u); break; } }
    }
    nloc = mine > 0u ? mine : 1u; nx = cnt > 0u ? cnt : 1u;
}
__device__ __forceinline__ void xcd_barrier(const XcdBarrier& b) {
    asm volatile("s_waitcnt vmcnt(0)" ::: "memory");
    __syncthreads();
    if (threadIdx.x == 0) {
        unsigned* bar = b.bar;
        __builtin_amdgcn_s_waitcnt(0);
        unsigned nloc = b.st[0], nx = b.st[1];
        if (nloc == 0u) { xcd_barrier_complete(bar, b.x, nloc, nx); b.st[0] = nloc; b.st[1] = nx; }
        const unsigned old = xb_add(&bar[XB_XSUB(b.x)], 1u);
        const unsigned gen = old / nloc;
        if (old + 1u == (gen + 1u) * nloc) {
            __builtin_amdgcn_fence(__ATOMIC_RELEASE, "agent");
            asm volatile("s_waitcnt vmcnt(0)" ::: "memory");
            const unsigned og = xb_add(&bar[XB_TOP], 1u);
            const unsigned tg = og / nx;
            if (og + 1u == (tg + 1u) * nx) xb_add(&bar[XB_TOPGEN], 1u);
            else XB_SPIN(xb_ld(&bar[XB_TOPGEN]) == tg, bar);
            __builtin_amdgcn_fence(__ATOMIC_ACQUIRE, "agent");
            xb_add(&bar[XB_XGEN(b.x)], 1u);
            asm volatile("s_waitcnt vmcnt(0)" ::: "memory");
        } else {
            if (old == gen * nloc) { __builtin_amdgcn_fence(__ATOMIC_RELEASE, "agent"); asm volatile("s_waitcnt vmcnt(0)" ::: "memory"); }
            XB_SPIN(xb_ld(&bar[XB_XGEN(b.x)]) == gen, bar);
            __builtin_amdgcn_fence(__ATOMIC_ACQUIRE, "agent");
            asm volatile("s_waitcnt vmcnt(0)" ::: "memory");
        }
    }
    __syncthreads();
}

struct Args {
    const float* in[34]; float* out; unsigned char* ws; int ph_lo, ph_hi, li, pad;
};
enum { I_XP = 0, I_XS, I_CK0, I_CV0, I_CK1, I_CV1, I_CK2, I_CV2, I_STC, I_CP, I_CS, I_WADA, I_BADA, I_F1NPRE, I_F1NPOST, I_F1W1, I_F1W3, I_F1W2, I_MNPRE, I_MNPOST, I_WIN, I_DWK, I_DWB, I_LNG, I_LNB,
       I_WCO, I_WAO, I_WOUT, I_RELB, I_F2NPRE, I_F2NPOST, I_F2W1, I_F2W3, I_F2W2 };

#define LDS_WAIT() asm volatile("s_waitcnt lgkmcnt(0)" ::: "memory")

__device__ __forceinline__ u32x4 pack8_(const f32x4 v0, const f32x4 v1) { return pg8::pack8(v0, v1); }
__device__ __forceinline__ void p0_transpose_item(const float* __restrict__ W, int K, int N, bf16_t* WT, int mode, LAS float* scr, int item, int lane, int ldk = 0, int koff = 0) {
    if (ldk == 0) ldk = K;
    const int nblk = N / 32, kb = item / nblk, nb = item % nblk, k0 = 64 * kb, n0 = 32 * nb;
#pragma unroll 8
    for (int i = 0; i < 32; ++i) { const int kk = 2 * i + (lane >> 5); scr[kk * 33 + (lane & 31)] = W[(size_t)(k0 + kk) * N + n0 + (lane & 31)]; }
    LDS_WAIT(); asm volatile("" ::: "memory");
    int r0;
    if (mode == 0) r0 = n0;
    else if (mode == 1) r0 = 256 * (n0 >> 7) + (n0 & 127);
    else if (mode == 2) r0 = 256 * (n0 >> 7) + 128 + (n0 & 127);
    else {
        if (n0 < 1024) r0 = 256 * (n0 >> 7) + (n0 & 127);
        else if (n0 < 2048) { const int n = n0 - 1024; r0 = 256 * (n >> 7) + 128 + (n & 127); }
        else if (n0 < 5120) r0 = n0;
        else if (n0 < 6656) r0 = 9216 + (n0 - 5120);
        else if (n0 < 8704) { const int n = n0 - 6656; r0 = 5120 + 256 * (n >> 7) + (n & 127); }
        else { const int n = n0 - 8704; r0 = 5120 + 256 * (n >> 7) + 128 + (n & 127); }
    }
    const int c = lane & 7;
#pragma unroll
    for (int j = 0; j < 4; ++j) { const int n = (lane >> 3) + 8 * j; const LAS float* s = scr + (8 * c) * 33 + n;
        u32x4 o; o.x = cvt_pk_bf16(s[0 * 33], s[1 * 33]); o.y = cvt_pk_bf16(s[2 * 33], s[3 * 33]); o.z = cvt_pk_bf16(s[4 * 33], s[5 * 33]); o.w = cvt_pk_bf16(s[6 * 33], s[7 * 33]);
        *(u32x4*)(WT + (size_t)(r0 + n) * ldk + koff + k0 + 8 * c) = o; }
    LDS_WAIT(); asm volatile("" ::: "memory");
}

typedef float f32x16 __attribute__((ext_vector_type(16)));
__device__ __forceinline__ void p0_adaln(const Args& a, LAS unsigned char* lds, int vcu, int G, int tid, int wid, int lane) {
    const float* __restrict__ wada = a.in[I_WADA]; const float* __restrict__ cp = a.in[I_CP]; const float* __restrict__ cs = a.in[I_CS];
    float* MOD = (float*)(a.ws + WS_MOD);
    LAS float* scp = (LAS float*)lds;
    LAS float* red = (LAS float*)(lds + 8192);
    for (int k = tid; k < DM; k += 512) { const float v = cp[k]; scp[k] = v * sigm(v); }
    const int bl = lane & 31, h = lane >> 5, kw = wid * 256;
    bf16x8 af[16];
#pragma unroll
    for (int s = 0; s < 16; ++s) { const float* p = cs + (size_t)bl * DM + kw + 16 * s + 8 * h; const f32x4 v0 = *(const f32x4*)p, v1 = *(const f32x4*)(p + 4);
        af[s] = __builtin_bit_cast(bf16x8, pack8_(v0 * sigm4(v0), v1 * sigm4(v1))); }
    __syncthreads();
    for (int tile = vcu; tile < NMODW / 32; tile += G) {
        const int n0 = tile * 32;
        f32x16 acc;
#pragma unroll
        for (int q = 0; q < 16; ++q) acc[q] = 0.f;
        float accp = 0.f;
        const float* wp = wada + (size_t)(kw + 8 * h) * NMODW + n0 + bl;
#pragma unroll
        for (int sb = 0; sb < 16; sb += 4) {
            float wv[4][8];
#pragma unroll
            for (int t = 0; t < 4; ++t)
#pragma unroll
                for (int j = 0; j < 8; ++j) wv[t][j] = __builtin_nontemporal_load(wp + (size_t)(16 * (sb + t) + j) * NMODW);
            __builtin_amdgcn_sched_barrier(0);
#pragma unroll
            for (int t = 0; t < 4; ++t) {
                const int s = sb + t;
                u32x4 bw; bw.x = cvt_pk_bf16(wv[t][0], wv[t][1]); bw.y = cvt_pk_bf16(wv[t][2], wv[t][3]); bw.z = cvt_pk_bf16(wv[t][4], wv[t][5]); bw.w = cvt_pk_bf16(wv[t][6], wv[t][7]);
                acc = __builtin_amdgcn_mfma_f32_32x32x16_bf16(af[s], __builtin_bit_cast(bf16x8, bw), acc, 0, 0, 0);
                const LAS f32x4* sp = (const LAS f32x4*)(scp + kw + 16 * s + 8 * h); const f32x4 p0 = sp[0], p1 = sp[1];
                accp += (p0[0] * wv[t][0] + p0[1] * wv[t][1]) + (p0[2] * wv[t][2] + p0[3] * wv[t][3]) + (p1[0] * wv[t][4] + p1[1] * wv[t][5]) + (p1[2] * wv[t][6] + p1[3] * wv[t][7]);
            }
            __builtin_amdgcn_sched_barrier(0);
        }
        accp += __shfl_xor(accp, 32);
#pragma unroll
        for (int q = 0; q < 16; ++q) red[(wid * 33 + (q & 3) + 8 * (q >> 2) + 4 * h) * 32 + bl] = acc[q];
        if (h == 0) red[(wid * 33 + 32) * 32 + bl] = accp;
        __syncthreads();
        for (int o = tid; o < 33 * 32; o += 512) { const int b = o >> 5, col = o & 31; float s = a.in[I_BADA][n0 + col];
#pragma unroll
            for (int w8 = 0; w8 < 8; ++w8) s += red[(w8 * 33 + b) * 32 + col];
            MOD[(size_t)(b == 32 ? 0 : b + 1) * NMODW + n0 + col] = s; }
        __syncthreads();
    }
}

constexpr int CP_N0 = 2 * 32 * 31, CP_N1 = 2 * 32 * 127, CP_N2 = 2 * 32 * 511, CP_NCHUNK = CP_N0 + CP_N1 + CP_N2;
__device__ __forceinline__ void p0_copy_chunk(const Args& a, int ci, int lane) {
    int g, per, r = ci;
    if (r < CP_N0) { g = 0; per = 31; } else { r -= CP_N0; if (r < CP_N1) { g = 1; per = 127; } else { r -= CP_N1; g = 2; per = 511; } }
    const int kvb = r / per, ch = r % per, kv = kvb >> 5, b = kvb & 31, W = 128 << (2 * g);
    const float* srcb = (g == 0 ? (kv ? a.in[I_CV0] : a.in[I_CK0]) : g == 1 ? (kv ? a.in[I_CV1] : a.in[I_CK1]) : (kv ? a.in[I_CV2] : a.in[I_CK2]));
    const f32x4* src = (const f32x4*)(srcb + ((size_t)b * W + 4) * 512) + (size_t)ch * 512 + lane;
    f32x4* dst = (f32x4*)(a.out + (kv ? o_sv(g) : o_sk(g)) + (size_t)b * W * 512) + (size_t)ch * 512 + lane;
    f32x4 v[8];
#pragma unroll
    for (int q = 0; q < 8; ++q) v[q] = __builtin_nontemporal_load(src + 64 * q);
#pragma unroll
    for (int q = 0; q < 8; ++q) __builtin_nontemporal_store(v[q], dst + 64 * q);
}

#ifndef FILL_UP
#define FILL_UP 5
#define FILL_7A 1
#define FILL_7B 1
#define FILL_8 1
#endif
constexpr int CPJ_CHUNKS = 16, CP_NJOBS = CP_NCHUNK / CPJ_CHUNKS, CW_QC = 128;
static_assert(CP_NCHUNK % CPJ_CHUNKS == 0, "copy jobs");
__device__ __forceinline__ void copy_filler(const Args& a, LAS unsigned char* lds, int tid, int wid, int lane, int maxjobs) {
    volatile LAS int* slot = (volatile LAS int*)(lds + MISC_OFF + 64);
    unsigned* ctr = (unsigned*)(a.ws + WS_CTL) + CW_QC;
    for (int it = 0; it < maxjobs; ++it) {
        if (tid == 0) slot[it & 1] = (int)__hip_atomic_fetch_add(ctr, 1u, __ATOMIC_RELAXED, __HIP_MEMORY_SCOPE_AGENT);
        __syncthreads();
        const int job = slot[it & 1];
        if (job >= CP_NJOBS) break;
        p0_copy_chunk(a, job * CPJ_CHUNKS + 2 * wid, lane); p0_copy_chunk(a, job * CPJ_CHUNKS + 2 * wid + 1, lane);
    }
    __syncthreads();
}
__device__ __forceinline__ void p0_weights(const Args& a, LAS unsigned char* lds, int vcu, int G, int tid, int wid, int lane) {
    {
        LAS float* scr = (LAS float*)(lds + wid * 16384);
        const int gw = vcu * NWAVES + wid, NGW = G * NWAVES;
        constexpr int I_UP = (DM / 64) * (FF / 32), I_DN = (FF / 64) * (DM / 32), I_IN = (DM / 64) * (10752 / 32), I_CO = (CC / 64) * (DM / 32), I_AO = (512 / 64) * (DM / 32), I_OUT = (DM / 64) * (DM / 32);
        constexpr int NITEMS = 4 * I_UP + 2 * I_DN + I_IN + I_CO + I_AO + I_OUT;
        unsigned char* ws = a.ws;
        for (int it = gw; it < NITEMS; it += NGW) {
            int r = it;
            if (r < I_UP) { p0_transpose_item(a.in[I_F1W1], DM, FF, (bf16_t*)(ws + WS_W13A), 1, scr, r, lane); continue; } r -= I_UP;
            if (r < I_UP) { p0_transpose_item(a.in[I_F1W3], DM, FF, (bf16_t*)(ws + WS_W13A), 2, scr, r, lane); continue; } r -= I_UP;
            if (r < I_DN) { p0_transpose_item(a.in[I_F1W2], FF, DM, (bf16_t*)(ws + WS_W2A), 0, scr, r, lane); continue; } r -= I_DN;
            if (r < I_IN) { p0_transpose_item(a.in[I_WIN], DM, 10752, (bf16_t*)(ws + WS_WIN), 3, scr, r, lane); continue; } r -= I_IN;
            if (r < I_CO) { p0_transpose_item(a.in[I_WCO], CC, DM, (bf16_t*)(ws + WS_WCO), 0, scr, r, lane, YAW, 0); continue; } r -= I_CO;
            if (r < I_AO) { p0_transpose_item(a.in[I_WAO], 512, DM, (bf16_t*)(ws + WS_WCO), 0, scr, r, lane, YAW, CC); continue; } r -= I_AO;
            if (r < I_OUT) { p0_transpose_item(a.in[I_WOUT], DM, DM, (bf16_t*)(ws + WS_WOUT), 0, scr, r, lane); continue; } r -= I_OUT;
            if (r < I_UP) { p0_transpose_item(a.in[I_F2W1], DM, FF, (bf16_t*)(ws + WS_W13B), 1, scr, r, lane); continue; } r -= I_UP;
            if (r < I_UP) { p0_transpose_item(a.in[I_F2W3], DM, FF, (bf16_t*)(ws + WS_W13B), 2, scr, r, lane); continue; } r -= I_UP;
            p0_transpose_item(a.in[I_F2W2], FF, DM, (bf16_t*)(ws + WS_W2B), 0, scr, r, lane);
        }
    }
    {
        const int gw = vcu * NWAVES + wid, NGW = G * NWAVES;
        for (int row = gw; row < 32 * 26; row += NGW) { const int b = row / 26, i = row % 26;
            const f32x4* src = (const f32x4*)(a.in[I_STC] + ((size_t)b * 30 + i + 4) * CC); f32x4* dst = (f32x4*)(a.out + O_SCONV + ((size_t)b * 30 + i) * CC);
#pragma unroll
            for (int q = 0; q < 4; ++q) dst[lane + 64 * q] = src[lane + 64 * q]; }
    }
}

template <int MODE, int NSLAB, bool SAMPLE_ONLY = false>
__device__ __forceinline__ void row_pass(const Args& a, int vcu, int G, int wid, int lane, const float* npost, int gate_i, float gsc, const float* npre, int shift_i, int scale_i) {
    const float* MOD = (const float*)(a.ws + WS_MOD);
    float* XR = (float*)(a.ws + WS_XR); const float* F = (const float*)(a.ws + WS_F); bf16_t* A = (bf16_t*)(a.ws + WS_A);
    const int gw = vcu * NWAVES + wid, NGW = G * NWAVES;
    for (int it = gw; it < (SAMPLE_ONLY ? MP - T : MP); it += NGW) {
        const int r = (it < NS) ? T + it : (it < MP - T ? MTOK + (it - NS) : it - (MP - T));
        if (r >= MTOK) {
            if (MODE != 3) {
#pragma unroll
                for (int j = 0; j < 8; ++j) *(u32x2*)(A + (size_t)r * DM + 4 * lane + 256 * j) = (u32x2){0u, 0u}; }
            continue;
        }
        const float* mod = MOD + (size_t)(r < T ? 0 : 1 + ((r - T) >> 2)) * NMODW;
        const float* xin = (r < T) ? a.in[I_XP] + (size_t)r * DM : a.in[I_XS] + (size_t)(r - T) * DM;
        f32x4 x[8];
        if (MODE == 0) {
#pragma unroll
            for (int j = 0; j < 8; ++j) x[j] = *(const f32x4*)(xin + 4 * lane + 256 * j);
        } else {
            f32x4 f[8], xo[8], gt[8], np[8];
            if (r >= T) {
#pragma unroll
                for (int jb = 0; jb < 8; ++jb) {
                    f32x4 sv[NSLAB > 0 ? NSLAB : 1];
                    const float* sl = (const float*)(a.ws + WS_SL) + (size_t)(r - T) * DM + 4 * lane + 256 * jb;
#pragma unroll
                    for (int q = 0; q < NSLAB; ++q) sv[q] = *(const f32x4*)(sl + (size_t)q * 128 * DM);
                    f32x4 s = sv[0];
#pragma unroll
                    for (int q = 1; q < NSLAB; ++q) s += sv[q];
                    f[jb] = s;
                    __builtin_amdgcn_sched_barrier(0);
                }
            }
#pragma unroll
            for (int j = 0; j < 8; ++j) { const int c = 4 * lane + 256 * j;
                if (r < T) f[j] = *(const f32x4*)(F + (size_t)r * DM + c);
                xo[j] = (MODE == 1) ? *(const f32x4*)(xin + c) : *(const f32x4*)(XR + (size_t)r * DM + c);
                gt[j] = *(const f32x4*)(mod + gate_i * DM + c); np[j] = *(const f32x4*)(npost + c); }
            float ss = 0.f;
#pragma unroll
            for (int j = 0; j < 8; ++j) ss += (f[j][0] * f[j][0] + f[j][1] * f[j][1]) + (f[j][2] * f[j][2] + f[j][3] * f[j][3]);
            const float rinv = __builtin_amdgcn_rsqf(wave_sum(ss) * (1.0f / DM) + EPS) * gsc;
#pragma unroll
            for (int j = 0; j < 8; ++j) { const int c = 4 * lane + 256 * j;
                x[j] = xo[j] + gt[j] * (f[j] * rinv * np[j]);
                if (MODE == 3) *(f32x4*)(a.out + O_Y + (size_t)r * DM + c) = x[j]; else *(f32x4*)(XR + (size_t)r * DM + c) = x[j]; }
        }
        if (MODE != 3) {
            f32x4 npr[8], sc[8], sh[8];
#pragma unroll
            for (int j = 0; j < 8; ++j) { const int c = 4 * lane + 256 * j; npr[j] = *(const f32x4*)(npre + c); sc[j] = *(const f32x4*)(mod + scale_i * DM + c); sh[j] = *(const f32x4*)(mod + shift_i * DM + c); }
            float ss = 0.f;
#pragma unroll
            for (int j = 0; j < 8; ++j) ss += (x[j][0] * x[j][0] + x[j][1] * x[j][1]) + (x[j][2] * x[j][2] + x[j][3] * x[j][3]);
            const float rinv = __builtin_amdgcn_rsqf(wave_sum(ss) * (1.0f / DM) + EPS);
#pragma unroll
            for (int j = 0; j < 8; ++j) { const int c = 4 * lane + 256 * j;
                const f32x4 h = (x[j] * rinv * npr[j]) * (sc[j] + 1.0f) + sh[j];
                *(u32x2*)(A + (size_t)r * DM + c) = (u32x2){cvt_pk_bf16(h[0], h[1]), cvt_pk_bf16(h[2], h[3])}; }
        }
    }
}

template <int MODE, int NSLAB>
__device__ __forceinline__ void sample_rows(const Args& a, LAS unsigned char* lds, int vcu, int G, int tid, int wid, int lane, const float* npost, int gate_i, float gsc, const float* npre, int shift_i, int scale_i) {
    const float* MOD = (const float*)(a.ws + WS_MOD);
    bf16_t* XR = (bf16_t*)(a.ws + WS_XR); bf16_t* A = (bf16_t*)(a.ws + WS_A);
    LAS float* red = (LAS float*)(lds + XL_OFF);
    for (int it = vcu; it < 2 * NS; it += G) {
        if (it >= NS) {
            if (MODE != 3) { const int r = MTOK + (it - NS); *(u32x2*)(A + (size_t)r * DM + 4 * tid) = (u32x2){0u, 0u}; }
            continue;
        }
        const int r = T + it, c = 256 * wid + 4 * lane;
        const float* mod = MOD + (size_t)(1 + (it >> 2)) * NMODW;
        const float* sl = (const float*)(a.ws + WS_SL) + (size_t)it * DM + c;
        f32x4 sv[NSLAB];
#pragma unroll
        for (int q = 0; q < NSLAB; ++q) sv[q] = *(const f32x4*)(sl + (size_t)q * 128 * DM);
        f32x4 xo;
        if (MODE == 1) xo = *(const f32x4*)(a.in[I_XS] + (size_t)it * DM + c);
        else { const u32x2 w = *(const u32x2*)(XR + (size_t)r * DM + c); xo = (f32x4){__builtin_bit_cast(float, w.x << 16), __builtin_bit_cast(float, w.x & 0xffff0000u), __builtin_bit_cast(float, w.y << 16), __builtin_bit_cast(float, w.y & 0xffff0000u)}; }
        const f32x4 gt = *(const f32x4*)(mod + gate_i * DM + c), np = *(const f32x4*)(npost + c);
        f32x4 f = sv[0];
#pragma unroll
        for (int q = 1; q < NSLAB; ++q) f += sv[q];
        const float ssw = wave_sum((f[0] * f[0] + f[1] * f[1]) + (f[2] * f[2] + f[3] * f[3]));
        __syncthreads();
        if (lane == 0) red[wid] = ssw;
        __syncthreads();
        float ss = 0.f;
#pragma unroll
        for (int w = 0; w < 8; ++w) ss += red[w];
        const float rinv = __builtin_amdgcn_rsqf(ss * (1.0f / DM) + EPS) * gsc;
        const f32x4 x = xo + gt * (f * rinv * np);
        if (MODE == 3) { *(f32x4*)(a.out + O_Y + (size_t)r * DM + c) = x; continue; }
        *(u32x2*)(XR + (size_t)r * DM + c) = (u32x2){cvt_pk_bf16(x[0], x[1]), cvt_pk_bf16(x[2], x[3])};
        const f32x4 npr = *(const f32x4*)(npre + c), sc = *(const f32x4*)(mod + scale_i * DM + c), sh = *(const f32x4*)(mod + shift_i * DM + c);
        const float ssw1 = wave_sum((x[0] * x[0] + x[1] * x[1]) + (x[2] * x[2] + x[3] * x[3]));
        if (lane == 0) red[8 + wid] = ssw1;
        __syncthreads();
        float ss1 = 0.f;
#pragma unroll
        for (int w = 0; w < 8; ++w) ss1 += red[8 + w];
        const float r1 = __builtin_amdgcn_rsqf(ss1 * (1.0f / DM) + EPS);
        const f32x4 h = (x * r1 * npr) * (sc + 1.0f) + sh;
        *(u32x2*)(A + (size_t)r * DM + c) = (u32x2){cvt_pk_bf16(h[0], h[1]), cvt_pk_bf16(h[2], h[3])};
    }
}

__device__ __forceinline__ void bias_table(const Args& a, LAS float* bt, int h, int tid) {
    __syncthreads();
    if (tid < 3 * 132) { const int g = tid / 132, m = tid % 132; bt[tid] = a.in[I_RELB][(int)BKT[g][m] * 12 + g * 4 + h] * LOG2E; }
    __syncthreads();
}

template <int G, int KT0, int NKTC, bool CQ = false>
__device__ __forceinline__ void attn_group(const bf16_t* __restrict__ QN, const bf16_t* __restrict__ KN, const bf16_t* __restrict__ VT, const LAS float* bias,
                                           int T0, int r, int h, int lane, float& m_run, float& l_run, f32x4 (&o)[8]) {
    constexpr int sh = 2 * G, d = 1 << sh, step = 16 / d, SEG = T / d;
    constexpr int QB = 3;
    static_assert(NKTC % QB == 0, "tile batches");
    const int i = lane & 15, grp = lane >> 4;
    static_assert(!CQ || (G == 0 && KT0 == 0), "compact queries: group 0 only");
    const int qrel = CQ ? r + (i & 7) + 16 * (i >> 3) : 0;
    const int rr = CQ ? 0 : (r & (d - 1)), qoff = CQ ? 0 : (r >> sh);
    const bf16_t* qp = QN + (size_t)(CQ ? T0 + qrel : T0 + r + 16 * i) * AW + G * 512 + h * 128 + 8 * grp;
    bf16x8 qf[4];
#pragma unroll
    for (int ks = 0; ks < 4; ++ks) qf[ks] = *(const bf16x8*)(qp + 32 * ks);
    const int jbase = (T0 >> sh) - 128 + 16 * KT0;
    const bf16_t* kbase = KN + (size_t)(G * 4 + h) * (T * 128) + (size_t)(rr * (SEG / 16)) * 2048;
    const bf16_t* vbase = VT + (size_t)(G * 4 + h) * (T * 128) + (size_t)(rr * (SEG / 16)) * 2048;
    f32x4 s[NKTC + 1];
#pragma unroll
    for (int kb = 0; kb < NKTC; kb += QB) {
        bf16x8 kf[QB][4];
#pragma unroll
        for (int t = 0; t < QB; ++t) {
            int tile = (jbase >> 4) + kb + t; tile = tile < 0 ? 0 : tile;
            const bf16_t* kp = kbase + (size_t)tile * 2048 + lane * 8;
#pragma unroll
            for (int ks = 0; ks < 4; ++ks) kf[t][ks] = *(const bf16x8*)(kp + 512 * ks);
        }
        __builtin_amdgcn_sched_barrier(0);
#pragma unroll
        for (int t = 0; t < QB; ++t) {
            f32x4 c = {0.f, 0.f, 0.f, 0.f};
#pragma unroll
            for (int ks = 0; ks < 4; ++ks) c = __builtin_amdgcn_mfma_f32_16x16x32_bf16(kf[t][ks], qf[ks], c, 0, 0, 0);
            s[kb + t] = c;
        }
        __builtin_amdgcn_sched_barrier(0);
    }
    s[NKTC] = (f32x4){0.f, 0.f, 0.f, 0.f};
    float mx = -1e30f;
    const int mq = (CQ ? qrel : qoff + step * i) + 128 - 16 * KT0 - 4 * grp;
#pragma unroll
    for (int kt = 0; kt < NKTC; ++kt)
#pragma unroll
        for (int reg = 0; reg < 4; ++reg) {
            const int kk = 16 * kt + 4 * grp + reg, mm = mq - 16 * kt - reg;
            const bool valid = ((unsigned)mm <= 128u) && (jbase + kk >= 0);
            const int mi = mm < 0 ? 0 : (mm > 128 ? 128 : mm);
            const float v = valid ? s[kt][reg] + bias[mi] : -__builtin_inff();
            s[kt][reg] = v; mx = fmaxf(mx, v);
        }
    mx = fmaxf(mx, __shfl_xor(mx, 16)); mx = fmaxf(mx, __shfl_xor(mx, 32));
    const float m_new = fmaxf(m_run, mx), alpha = ex2(m_run - m_new);
    float ls = 0.f;
#pragma unroll
    for (int kt = 0; kt < NKTC; ++kt)
#pragma unroll
        for (int reg = 0; reg < 4; ++reg) { const float p = ex2(s[kt][reg] - m_new); s[kt][reg] = p; ls += p; }
    ls += __shfl_xor(ls, 16); ls += __shfl_xor(ls, 32);
    l_run = l_run * alpha + ls; m_run = m_new;
#pragma unroll
    for (int dt = 0; dt < 8; ++dt) o[dt] = o[dt] * alpha;
    constexpr int NKS2 = (NKTC + 1) / 2;
    constexpr int PB = 1;
#pragma unroll
    for (int kb2 = 0; kb2 < NKS2; kb2 += PB) {
        u32x2 vl[PB][8], vh[PB][8];
#pragma unroll
        for (int t = 0; t < PB; ++t) if (kb2 + t < NKS2) {
            int t0 = (jbase >> 4) + 2 * (kb2 + t), t1 = t0 + 1;
            t0 = t0 < 0 ? 0 : t0; t1 = t1 < 0 ? 0 : (t1 > SEG / 16 - 1 ? SEG / 16 - 1 : t1);
            const bf16_t* p0 = vbase + (size_t)t0 * 2048 + lane * 4; const bf16_t* p1 = vbase + (size_t)t1 * 2048 + lane * 4;
#pragma unroll
            for (int dt = 0; dt < 8; ++dt) { vl[t][dt] = *(const u32x2*)(p0 + 256 * dt); vh[t][dt] = *(const u32x2*)(p1 + 256 * dt); }
        }
        __builtin_amdgcn_sched_barrier(0);
#pragma unroll
        for (int t = 0; t < PB; ++t) if (kb2 + t < NKS2) {
            const int ks2 = kb2 + t;
            u32x4 pw;
            pw.x = cvt_pk_bf16(s[2 * ks2][0], s[2 * ks2][1]); pw.y = cvt_pk_bf16(s[2 * ks2][2], s[2 * ks2][3]);
            pw.z = cvt_pk_bf16(s[2 * ks2 + 1][0], s[2 * ks2 + 1][1]); pw.w = cvt_pk_bf16(s[2 * ks2 + 1][2], s[2 * ks2 + 1][3]);
            const bf16x8 pf = __builtin_bit_cast(bf16x8, pw);
#pragma unroll
            for (int dt = 0; dt < 8; ++dt) {
                const bf16x8 vf = __builtin_bit_cast(bf16x8, (u32x4){vl[t][dt].x, vl[t][dt].y, vh[t][dt].x, vh[t][dt].y});
                o[dt] = __builtin_amdgcn_mfma_f32_16x16x32_bf16(vf, pf, o[dt], 0, 0, 0);
            }
        }
        __builtin_amdgcn_sched_barrier(0);
    }
}

__device__ __forceinline__ void attn_prompt_unit(const Args& a, LAS unsigned char* lds, int unit, int tid, int wid, int lane) {
    const int half = unit & 1, h = (unit >> 1) & 3, T0 = (unit >> 3) * 256;
    LAS float* bt = (LAS float*)lds;
    bias_table(a, bt, h, tid);
    const bf16_t* QN = (const bf16_t*)(a.ws + WS_QN); const bf16_t* KN = (const bf16_t*)(a.ws + WS_KN); const bf16_t* VT = (const bf16_t*)(a.ws + WS_VT);
    bf16_t* ATT = (bf16_t*)(a.ws + WS_YA) + CC;
    const int r = 8 * half + wid;
    float m_run = -1e30f, l_run = 0.f; f32x4 o[8];
#pragma unroll
    for (int dt = 0; dt < 8; ++dt) o[dt] = (f32x4){0.f, 0.f, 0.f, 0.f};
    const int i = lane & 15, grp = lane >> 4, t = T0 + r + 16 * i;
    LAS float* mg = (LAS float*)(lds + 4096);
    attn_group<0, 0, 12, true>(QN, KN, VT, bt, T0 + 32 * wid, 8 * half, h, lane, m_run, l_run, o);
    { LAS float* dstq = mg + ((i & 7) * 16 + 2 * wid + (i >> 3)) * 132;
#pragma unroll
      for (int dt = 0; dt < 8; ++dt) *(LAS f32x4*)(dstq + 16 * dt + 4 * grp) = o[dt];
      if (grp == 0) { dstq[128] = m_run; dstq[129] = l_run; } }
    m_run = -1e30f; l_run = 0.f;
#pragma unroll
    for (int dt = 0; dt < 8; ++dt) o[dt] = (f32x4){0.f, 0.f, 0.f, 0.f};
    attn_group<1, 0, 12>(QN, KN, VT, bt + 132, T0, r, h, lane, m_run, l_run, o);
    attn_group<2, 0, 9>(QN, KN, VT, bt + 264, T0, r, h, lane, m_run, l_run, o);
    __syncthreads();
    { const LAS float* srcq = mg + (wid * 16 + i) * 132;
      const float m0 = srcq[128], l0 = srcq[129], mm_ = fmaxf(m_run, m0), a1 = ex2(m_run - mm_), a0 = ex2(m0 - mm_);
      l_run = l_run * a1 + l0 * a0;
#pragma unroll
      for (int dt = 0; dt < 8; ++dt) o[dt] = o[dt] * a1 + *(const LAS f32x4*)(srcq + 16 * dt + 4 * grp) * a0; }
    const float inv = 1.0f / l_run;
#pragma unroll
    for (int dt = 0; dt < 8; ++dt) { const f32x4 v = o[dt] * inv; *(u32x2*)(ATT + (size_t)t * YAW + h * 128 + 16 * dt + 4 * grp) = (u32x2){cvt_pk_bf16(v[0], v[1]), cvt_pk_bf16(v[2], v[3])}; }
}

template <int G>
__device__ __forceinline__ void attn_sample_task(const float* __restrict__ ck, const float* __restrict__ cv, const float* nk, const float* nv, const bf16_t* QN, const LAS float* bt, LAS float* pp,
                                                 int b, int h, int j, int lane, int pb0 = 0, int pb1 = 65) {
    constexpr int sh = 2 * G, W = 128 << sh, NB = 13;
    const int half = lane >> 5, sub = lane & 31;
    const bf16x4 qb = *(const bf16x4*)(QN + (size_t)(T + b * 4 + j) * AW + G * 512 + h * 128 + 4 * sub);
    const f32x4 q = {bf2f((unsigned short)qb[0]), bf2f((unsigned short)qb[1]), bf2f((unsigned short)qb[2]), bf2f((unsigned short)qb[3])};
    const size_t hb = (size_t)b * W * 512 + h * 128 + 4 * sub;
    float mr = -1e30f, l = 0.f; f32x4 o = {0.f, 0.f, 0.f, 0.f};
#pragma unroll 1
    for (int pb = pb0; pb < pb1; pb += NB) {
        f32x4 kx[NB], vx[NB];
#pragma unroll
        for (int t = 0; t < NB; ++t) {
            const int m = 2 * (pb + t) + half, mc = m <= 128 ? m : 128;
            const int idx = W + j - (mc << sh);
            const bool isnew = idx >= W;
            const size_t ro = hb + (size_t)(isnew ? idx - 4 : idx) * 512;
            kx[t] = *(const f32x4*)((isnew ? nk : ck) + ro); vx[t] = *(const f32x4*)((isnew ? nv : cv) + ro);
        }
        __builtin_amdgcn_sched_barrier(0);
#pragma unroll
        for (int t = 0; t < NB; ++t) {
            const int m = 2 * (pb + t) + half; const bool valid = m <= 128; const int mc = valid ? m : 128;
            float dp = (q[0] * kx[t][0] + q[1] * kx[t][1]) + (q[2] * kx[t][2] + q[3] * kx[t][3]);
            dp += __shfl_xor(dp, 1); dp += __shfl_xor(dp, 2); dp += __shfl_xor(dp, 4); dp += __shfl_xor(dp, 8); dp += __shfl_xor(dp, 16);
            const float s = valid ? dp + bt[G * 132 + mc] : -__builtin_inff();
            const float mn = fmaxf(mr, s), al = ex2(mr - mn), p = ex2(s - mn);
            l = l * al + p; o = o * al + vx[t] * p; mr = mn;
        }
        __builtin_amdgcn_sched_barrier(0);
    }
    const float mo = __shfl_xor(mr, 32), lo = __shfl_xor(l, 32);
    const f32x4 oo = {__shfl_xor(o[0], 32), __shfl_xor(o[1], 32), __shfl_xor(o[2], 32), __shfl_xor(o[3], 32)};
    const float M = fmaxf(mr, mo), e0 = ex2(mr - M), e1 = ex2(mo - M);
    l = l * e0 + lo * e1; o = o * e0 + oo * e1;
    if (lane < 32) { if (lane == 0) { pp[0] = M; pp[1] = l; } *(LAS f32x4*)(pp + 4 + 4 * sub) = o; }
}
__device__ __forceinline__ void attn_sample_item(const Args& a, LAS unsigned char* lds, int item, int tid, int wid, int lane) {
    const int b = item >> 2, h = item & 3;
    LAS float* bt = (LAS float*)lds; LAS float* part = (LAS float*)(lds + 2048);
    bias_table(a, bt, h, tid);
    const bf16_t* QN = (const bf16_t*)(a.ws + WS_QN); bf16_t* ATT = (bf16_t*)(a.ws + WS_YA) + CC;
    if (wid < 4) { attn_sample_task<0>(a.in[I_CK0], a.in[I_CV0], a.out + O_SK0, a.out + O_SV0, QN, bt, part + wid * 132, b, h, wid, lane);
                   attn_sample_task<2>(a.in[I_CK2], a.in[I_CV2], a.out + O_SK2, a.out + O_SV2, QN, bt, part + (8 + wid) * 132, b, h, wid, lane, 0, 39); }
    else { attn_sample_task<1>(a.in[I_CK1], a.in[I_CV1], a.out + O_SK1, a.out + O_SV1, QN, bt, part + wid * 132, b, h, wid - 4, lane);
           attn_sample_task<2>(a.in[I_CK2], a.in[I_CV2], a.out + O_SK2, a.out + O_SV2, QN, bt, part + (8 + wid) * 132, b, h, wid - 4, lane, 39, 65); }
    __syncthreads();
    if (wid < 4) {
        const int j = wid;
        const LAS float* p0 = part + j * 132; const LAS float* p1 = part + (4 + j) * 132; const LAS float* p2 = part + (8 + j) * 132; const LAS float* p3 = part + (12 + j) * 132;
        const float M = fmaxf(fmaxf(p0[0], p1[0]), fmaxf(p2[0], p3[0])), e0 = ex2(p0[0] - M), e1 = ex2(p1[0] - M), e2 = ex2(p2[0] - M), e3 = ex2(p3[0] - M);
        const float inv = 1.0f / ((p0[1] * e0 + p1[1] * e1) + (p2[1] * e2 + p3[1] * e3));
        const float v0 = ((p0[4 + 2 * lane] * e0 + p1[4 + 2 * lane] * e1) + (p2[4 + 2 * lane] * e2 + p3[4 + 2 * lane] * e3)) * inv, v1 = ((p0[5 + 2 * lane] * e0 + p1[5 + 2 * lane] * e1) + (p2[5 + 2 * lane] * e2 + p3[5 + 2 * lane] * e3)) * inv;
        *(unsigned*)(ATT + (size_t)(T + b * 4 + j) * YAW + h * 128 + 2 * lane) = cvt_pk_bf16(v0, v1);
    }
    __syncthreads();
}

template <int NT, bool SAMPLE>
__device__ __forceinline__ void conv_item(const Args& a, LAS unsigned char* lds, int item, int tid, int wid, int lane) {
    const bf16_t* U = (const bf16_t*)(a.ws + WS_U); bf16_t* YN = (bf16_t*)(a.ws + WS_YA);
    LAS float* yl = (LAS float*)lds;
    __syncthreads();
    const int c0 = 2 * tid;
    f32x2 ur[NT + 30];
    const int t0 = SAMPLE ? T + item * 4 : item * NT;
#pragma unroll
    for (int i = 0; i < NT + 30; ++i) {
        if (SAMPLE) { if (i < 30) ur[i] = *(const f32x2*)(a.in[I_STC] + ((size_t)item * 30 + i) * CC + c0); else { const unsigned w = *(const unsigned*)(U + (size_t)(t0 + i - 30) * CC + c0); ur[i] = (f32x2){__builtin_bit_cast(float, w << 16), __builtin_bit_cast(float, w & 0xffff0000u)}; } }
        else { const int t = t0 - 30 + i; const unsigned w = (t >= 0) ? *(const unsigned*)(U + (size_t)t * CC + c0) : 0u; ur[i] = (f32x2){__builtin_bit_cast(float, w << 16), __builtin_bit_cast(float, w & 0xffff0000u)}; }
    }
    f32x2 y[NT];
    const f32x2 bias = *(const f32x2*)(a.in[I_DWB] + c0);
#pragma unroll
    for (int ti = 0; ti < NT; ++ti) y[ti] = bias;
#pragma unroll
    for (int k = 0; k < 31; ++k) { const f32x2 w = *(const f32x2*)(a.in[I_DWK] + (size_t)k * CC + c0);
#pragma unroll
        for (int ti = 0; ti < NT; ++ti) y[ti] += w * ur[ti + k]; }
#pragma unroll
    for (int ti = 0; ti < NT; ++ti) *(LAS f32x2*)(yl + ti * CC + c0) = y[ti];
    __syncthreads();
    for (int ti = wid; ti < NT; ti += 8) {
        f32x4 v[4]; float s = 0.f;
#pragma unroll
        for (int q = 0; q < 4; ++q) { v[q] = *(const LAS f32x4*)(yl + ti * CC + 4 * lane + 256 * q); s += (v[q][0] + v[q][1]) + (v[q][2] + v[q][3]); }
        const float mu = wave_sum(s) * (1.0f / CC); float s2 = 0.f;
#pragma unroll
        for (int q = 0; q < 4; ++q) { v[q] = v[q] - mu; s2 += (v[q][0] * v[q][0] + v[q][1] * v[q][1]) + (v[q][2] * v[q][2] + v[q][3] * v[q][3]); }
        const float rstd = __builtin_amdgcn_rsqf(wave_sum(s2) * (1.0f / CC) + EPS);
#pragma unroll
        for (int q = 0; q < 4; ++q) { const int c = 4 * lane + 256 * q;
            const f32x4 g = *(const f32x4*)(a.in[I_LNG] + c), bb = *(const f32x4*)(a.in[I_LNB] + c);
            f32x4 yn = v[q] * rstd * g + bb; yn = yn * sigm4(yn);
            *(u32x2*)(YN + (size_t)(t0 + ti) * YAW + c) = (u32x2){cvt_pk_bf16(yn[0], yn[1]), cvt_pk_bf16(yn[2], yn[3])}; }
    }
    __syncthreads();
}

constexpr int N_PHASES = 13;
__global__ void __launch_bounds__(NWAVES * 64, 2) mk_fwd(Args args) {
    extern __shared__ __attribute__((aligned(16))) unsigned char lds_raw[];
    LAS unsigned char* lds = (LAS unsigned char*)lds_raw;
    volatile LAS unsigned* MISC = (volatile LAS unsigned*)(lds + MISC_OFF);
    const int tid = threadIdx.x, lane = tid & 63, wid = __builtin_amdgcn_readfirstlane(tid >> 6);
    const int G = gridDim.x; const int bx = blockIdx.x; const int vcu = (G % 8 == 0) ? (bx % 8) * (G / 8) + bx / 8 : bx;
    unsigned char* ws = args.ws;
    gu32* ctl = (gu32*)(ws + WS_CTL);
    for (int u = tid; u < (LDS_BYTES - LDSCTL_OFF) / 4; u += NWAVES * 64) ((LAS unsigned*)(lds + LDSCTL_OFF))[u] = 0u;
    __syncthreads();
    XcdBarrier bar; bar.bar = (unsigned*)(ctl + CW_BAR); bar.x = 0; bar.st = nullptr;
    if (MK_N_LAUNCHES == 1) bar = xcd_barrier_post((unsigned*)(ctl + CW_BAR), MISC + 8);
    const int lo = args.ph_lo, hi = args.ph_hi;
#ifndef PH_MASK
#define PH_MASK 0x1fff
#endif
#define IN(k) ((((PH_MASK) >> (k)) & 1) && lo <= (k) && (k) < hi)
#define SEAM(k) do { if (IN(k) && IN((k) + 1)) xcd_barrier(bar); } while (0)

    bf16_t* A = (bf16_t*)(ws + WS_A); float* F = (float*)(ws + WS_F); bf16_t* GH = (bf16_t*)(ws + WS_GH);

    if (IN(0)) { p0_adaln(args, lds, vcu, G, tid, wid, lane); }
    SEAM(0);
    if (IN(1)) { row_pass<0, 0>(args, vcu, G, wid, lane, nullptr, 0, 0.f, args.in[I_F1NPRE], 0, 1); p0_weights(args, lds, vcu, G, tid, wid, lane); }
    SEAM(1);
    if (IN(2)) { pg8::SimpleSched S; S.init(A, ws + WS_W13A, MP, 2 * FF, DM, G, bx); pg8::EpiSwiglu E{GH}; pg8::gemm_phase(lds, DM, S, E); if ((1452 - bx + G - 1) / G < (1452 + G - 1) / G) copy_filler(args, lds, tid, wid, lane, FILL_UP); }
    SEAM(2);
    if (IN(3)) { pg8::DownSched S; S.init(GH, ws + WS_W2A, FF, 22, G, bx);
        pg8::EpiDownFused<1> E{(float*)(ws + WS_SL), args.in[I_XP], (bf16_t*)(ws + WS_XR), A, args.out, (const float*)(ws + WS_MOD), args.in[I_F1NPOST], args.in[I_MNPRE], (float*)(ws + WS_XS), (unsigned*)(ctl + CW_XC), lds + XL_OFF};
        pg8::gemm_phase(lds, FF, S, E); }
    SEAM(3);
    if (IN(4)) { sample_rows<1, 22>(args, lds, vcu, G, tid, wid, lane, args.in[I_F1NPOST], 2, 0.5f, args.in[I_MNPRE], 3, 4); }
    SEAM(4);
    if (IN(5)) { pg8::MixSched S; S.init(A, ws + WS_WIN, G, bx);
        pg8::EpiMixIn E{(bf16_t*)(ws + WS_U), (bf16_t*)(ws + WS_QN), (bf16_t*)(ws + WS_KN), (bf16_t*)(ws + WS_VT), (bf16_t*)(ws + WS_SGC), (bf16_t*)(ws + WS_SGA), args.out};
        pg8::gemm_phase(lds, DM, S, E); if ((pg8::MixSched::N2 - bx + G - 1) / G < (pg8::MixSched::N2 + G - 1) / G) copy_filler(args, lds, tid, wid, lane, FILL_UP); }
    SEAM(5);
    if (IN(6)) {
#ifndef P6_PARTS
#define P6_PARTS 15
#endif
        if (P6_PARTS & 1) for (int u = vcu; u < 256; u += G) attn_prompt_unit(args, lds, u, tid, wid, lane);
        if (G == 256) {
            if (vcu < 128) { if (P6_PARTS & 2) attn_sample_item(args, lds, vcu, tid, wid, lane); }
            else { for (int e = vcu - 128; e < 544; e += 128) { if (e < 512) { if (P6_PARTS & 4) conv_item<16, false>(args, lds, e, tid, wid, lane); } else { if (P6_PARTS & 8) conv_item<4, true>(args, lds, e - 512, tid, wid, lane); } } }
        } else
        for (int e = vcu; e < 128 + 512 + 32; e += G) {
            if (e < 128) { if (P6_PARTS & 2) attn_sample_item(args, lds, e, tid, wid, lane); }
            else if (e < 128 + 512) { if (P6_PARTS & 4) conv_item<16, false>(args, lds, e - 128, tid, wid, lane); }
            else { if (P6_PARTS & 8) conv_item<4, true>(args, lds, e - 640, tid, wid, lane); }
        }
        { bf16_t* YA = (bf16_t*)(ws + WS_YA);
          for (int i = bx * 512 + tid; i < 128 * YAW / 8; i += G * 512) *(u32x4*)(YA + (size_t)MTOK * YAW + 8 * i) = (u32x4){0u, 0u, 0u, 0u}; }
    }
    SEAM(6);
    if (IN(7)) { pg8::PairSched S; S.init(ws + WS_YA, ws + WS_WCO, G, bx); pg8::EpiMixPair E{(const bf16_t*)(ws + WS_SGC), (const bf16_t*)(ws + WS_SGA), (bf16_t*)(ws + WS_MG)};
        pg8::gemm_phase(lds, YAW, S, E); if (bx >= 8) copy_filler(args, lds, tid, wid, lane, FILL_7A + FILL_7B); }
    SEAM(7);
    if (IN(8)) { pg8::DownSched S; S.init(ws + WS_MG, ws + WS_WOUT, DM, 8, G, bx);
        pg8::EpiDownFused<2> E{(float*)(ws + WS_SL), nullptr, (bf16_t*)(ws + WS_XR), A, args.out, (const float*)(ws + WS_MOD), args.in[I_MNPOST], args.in[I_F2NPRE], (float*)(ws + WS_XS) + 2 * 32 * 256 * 8, (unsigned*)(ctl + CW_XC) + 2 * 32 * 64, lds + XL_OFF};
        pg8::gemm_phase(lds, DM, S, E); if (bx >= 64) copy_filler(args, lds, tid, wid, lane, FILL_8); }
    SEAM(8);
    if (IN(9)) { sample_rows<2, 8>(args, lds, vcu, G, tid, wid, lane, args.in[I_MNPOST], 5, 1.0f, args.in[I_F2NPRE], 6, 7); }
    SEAM(9);
    if (IN(10)) { pg8::SimpleSched S; S.init(A, ws + WS_W13B, MP, 2 * FF, DM, G, bx); pg8::EpiSwiglu E{GH}; pg8::gemm_phase(lds, DM, S, E); if ((1452 - bx + G - 1) / G < (1452 + G - 1) / G) copy_filler(args, lds, tid, wid, lane, FILL_UP); }
    SEAM(10);
    if (IN(11)) { pg8::DownSched S; S.init(GH, ws + WS_W2B, FF, 22, G, bx);
        pg8::EpiDownFused<3> E{(float*)(ws + WS_SL), nullptr, (bf16_t*)(ws + WS_XR), A, args.out, (const float*)(ws + WS_MOD), args.in[I_F2NPOST], nullptr, (float*)(ws + WS_XS) + 4 * 32 * 256 * 8, (unsigned*)(ctl + CW_XC) + 4 * 32 * 64, lds + XL_OFF};
        pg8::gemm_phase(lds, FF, S, E); }
    SEAM(11);
    if (IN(12)) { const int lane_ = (int)__builtin_amdgcn_mbcnt_hi(~0u, __builtin_amdgcn_mbcnt_lo(~0u, 0u)), tid_ = (wid << 6) | lane_;
        sample_rows<3, 22>(args, lds, vcu, G, tid_, wid, lane_, args.in[I_F2NPOST], 8, 0.5f, nullptr, 0, 0); copy_filler(args, lds, tid_, wid, lane_, 1 << 30); }
#undef IN
#undef SEAM
}

extern "C" void kernel_launch(void* const* d_in, const int* in_sizes, int n_in, void* d_out, int out_size, void* d_ws, size_t ws_size, hipStream_t stream) {
    static int grid = 0;
    if (grid == 0) {
        if (n_in != 34 || (size_t)out_size != O_END || ws_size < WS_END) { fprintf(stderr, "kernel_launch: unexpected shapes: n_in %d out %d ws %zu (need %zu); nothing launched\n", n_in, out_size, ws_size, (size_t)WS_END); grid = -1; return; }
        int dev = 0, cus = 0, per_cu = 0;
        if (hipGetDevice(&dev) != hipSuccess || hipDeviceGetAttribute(&cus, hipDeviceAttributeMultiprocessorCount, dev) != hipSuccess) { grid = -1; return; }
        if (hipFuncSetAttribute((const void*)mk_fwd, hipFuncAttributeMaxDynamicSharedMemorySize, LDS_BYTES) != hipSuccess) { fprintf(stderr, "kernel_launch: hipFuncSetAttribute failed\n"); grid = -1; return; }
        if (hipOccupancyMaxActiveBlocksPerMultiprocessor(&per_cu, (const void*)mk_fwd, NWAVES * 64, LDS_BYTES) != hipSuccess || per_cu < 1) { fprintf(stderr, "kernel_launch: occupancy query says %d\n", per_cu); per_cu = 1; }
        (void)hipGetLastError();
        grid = cus * (per_cu < 1 ? 1 : 1);
    }
    if (grid < 0) return;
    (void)hipMemsetAsync((char*)d_ws + WS_CTL, 0, CTL_ZERO_BYTES, stream);
    Args a{};
    for (int i = 0; i < 34; ++i) a.in[i] = (const float*)d_in[i];
    a.out = (float*)d_out; a.ws = (unsigned char*)d_ws;
    if (MK_N_LAUNCHES == 1) { a.ph_lo = 0; a.ph_hi = N_PHASES; a.li = 0; hipLaunchKernelGGL(mk_fwd, dim3(grid), dim3(NWAVES * 64), LDS_BYTES, stream, a); }
    else for (int li = 0; li < N_PHASES; ++li) { a.ph_lo = li; a.ph_hi = li + 1; a.li = li; hipLaunchKernelGGL(mk_fwd, dim3(grid), dim3(NWAVES * 64), LDS_BYTES, stream, a); }
}
```

```cpp
#include <hip/hip_runtime.h>
#include <cstdio>
#include <cstdint>

#ifndef MK_N_LAUNCHES
#define MK_N_LAUNCHES 1
#endif

constexpr int T = 8192, NS = 128, MTOK = T + NS, MP = 8448;
constexpr int DM = 2048, FF = 5632, CC = 1024, AW = 1536, NMODW = 9 * DM;
constexpr float EPS = 1e-6f;
constexpr float LOG2E = 1.4426950408889634f;
constexpr float QSCALE = 0.08838834764831845f * LOG2E;

#define GAS __attribute__((address_space(1)))
#define LAS __attribute__((address_space(3)))
typedef unsigned short bf16_t;
typedef short bf16x8 __attribute__((ext_vector_type(8)));
typedef short bf16x4 __attribute__((ext_vector_type(4)));
typedef float f32x4 __attribute__((ext_vector_type(4)));
typedef float f32x2 __attribute__((ext_vector_type(2)));
typedef unsigned u32x4 __attribute__((ext_vector_type(4)));
typedef unsigned u32x2 __attribute__((ext_vector_type(2)));
typedef GAS unsigned gu32;

typedef __bf16 bf16v2 __attribute__((ext_vector_type(2)));
__device__ __forceinline__ unsigned cvt_pk_bf16(float lo, float hi) { const f32x2 v = {lo, hi}; return __builtin_bit_cast(unsigned, __builtin_convertvector(v, bf16v2)); }
__device__ __forceinline__ float bf2f(unsigned short h) { return __builtin_bit_cast(float, (unsigned)h << 16); }
__device__ __forceinline__ float sigm(float x) { return __builtin_amdgcn_rcpf(1.0f + __builtin_amdgcn_exp2f(-LOG2E * x)); }
__device__ __forceinline__ float ex2(float x) { return __builtin_amdgcn_exp2f(x); }
__device__ __forceinline__ f32x4 sigm4(const f32x4 v) { return (f32x4){sigm(v[0]), sigm(v[1]), sigm(v[2]), sigm(v[3])}; }
__device__ __forceinline__ float wave_sum(float v) {
#pragma unroll
    for (int o = 1; o < 64; o <<= 1) v += __shfl_xor(v, o);
    return v;
}

constexpr size_t O_Y = 0;
constexpr size_t O_PK0 = O_Y + (size_t)MTOK * DM, O_PV0 = O_PK0 + 128 * 512, O_PK1 = O_PV0 + 128 * 512, O_PV1 = O_PK1 + 512 * 512, O_PK2 = O_PV1 + 512 * 512, O_PV2 = O_PK2 + 2048 * 512;
constexpr size_t O_PCONV = O_PV2 + 2048 * 512;
constexpr size_t O_SK0 = O_PCONV + 30 * 1024, O_SV0 = O_SK0 + 32ull * 128 * 512, O_SK1 = O_SV0 + 32ull * 128 * 512, O_SV1 = O_SK1 + 32ull * 512 * 512, O_SK2 = O_SV1 + 32ull * 512 * 512, O_SV2 = O_SK2 + 32ull * 2048 * 512;
constexpr size_t O_SCONV = O_SV2 + 32ull * 2048 * 512, O_END = O_SCONV + 32ull * 30 * 1024;
static_assert(O_END == 108886016ull, "output size");
__device__ __forceinline__ size_t o_pk(int g) { return g == 0 ? O_PK0 : (g == 1 ? O_PK1 : O_PK2); }
__device__ __forceinline__ size_t o_pv(int g) { return g == 0 ? O_PV0 : (g == 1 ? O_PV1 : O_PV2); }
__device__ __forceinline__ size_t o_sk(int g) { return g == 0 ? O_SK0 : (g == 1 ? O_SK1 : O_SK2); }
__device__ __forceinline__ size_t o_sv(int g) { return g == 0 ? O_SV0 : (g == 1 ? O_SV1 : O_SV2); }

constexpr size_t MiB = 1u << 20;
constexpr size_t WS_CTL = 0, CTL_ZERO_BYTES = 256 * 1024;
constexpr size_t WS_MOD = 1 * MiB;
constexpr size_t WS_W13A = 4 * MiB, WS_W2A = 48 * MiB, WS_WIN = 70 * MiB, WS_WCO = 112 * MiB, WS_WAO = 116 * MiB, WS_WOUT = 118 * MiB, WS_W13B = 126 * MiB, WS_W2B = 170 * MiB;
constexpr size_t WS_A = 192 * MiB;
constexpr size_t WS_XR = 225 * MiB;
constexpr size_t WS_F = 291 * MiB;
constexpr size_t WS_GH = 357 * MiB;
constexpr size_t WS_U = 448 * MiB;
constexpr size_t WS_QN = 481 * MiB, WS_KN = 506 * MiB;
constexpr size_t WS_VT = 531 * MiB;
constexpr size_t WS_SGC = 555 * MiB, WS_SGA = 588 * MiB;
constexpr size_t WS_YA = 621 * MiB;
constexpr int YAW = 1536;
constexpr size_t WS_T1 = 647 * MiB;
constexpr size_t WS_MG = 713 * MiB;
constexpr size_t WS_SL = 746 * MiB;
constexpr size_t WS_XS = 769 * MiB;
constexpr size_t WS_END = 771 * MiB;
static_assert(WS_MOD + 33ull * NMODW * 4 <= WS_W13A && WS_W13A + 11264ull * 2048 * 2 <= WS_W2A && WS_W2A + 2048ull * 5632 * 2 <= WS_WIN && WS_WIN + 10752ull * 2048 * 2 <= WS_WCO, "ws map 1");
static_assert(WS_WCO + 2048ull * 1536 * 2 <= WS_WOUT && WS_WOUT + 2048ull * 2048 * 2 <= WS_W13B && WS_W13B + 11264ull * 2048 * 2 <= WS_W2B && WS_W2B + 2048ull * 5632 * 2 <= WS_A, "ws map 2");
static_assert(WS_A + (size_t)MP * DM * 2 <= WS_XR && WS_XR + (size_t)MP * DM * 4 <= WS_F && WS_F + (size_t)MP * DM * 4 <= WS_GH && WS_GH + (size_t)MP * FF * 2 <= WS_U && WS_U + (size_t)MP * CC * 4 <= WS_QN, "ws map 3");
static_assert(WS_QN + (size_t)MP * AW * 2 <= WS_KN && WS_KN + (size_t)MP * AW * 2 <= WS_VT && WS_VT + (size_t)AW * T * 2 <= WS_SGC && WS_SGC + (size_t)MP * DM * 2 <= WS_SGA && WS_SGA + (size_t)MP * DM * 2 <= WS_YA, "ws map 4");
static_assert(WS_YA + (size_t)MP * YAW * 2 <= WS_T1 && WS_T1 + (size_t)MP * DM * 4 <= WS_MG && WS_MG + (size_t)MP * DM * 2 <= WS_SL && WS_SL + 22ull * 128 * DM * 4 <= WS_XS && WS_XS + 3ull * 2 * 32 * 256 * 8 * 4 <= WS_END, "ws map 5");
constexpr int CW_BAR = 4096;
constexpr int CW_XC = 32768;
static_assert((CW_XC + 3 * 2 * 32 * 64) * 4 <= (int)CTL_ZERO_BYTES, "exchange counters inside the zeroed region");

constexpr int RING_BYTES = 131072, LDSCTL_OFF = RING_BYTES, MISC_OFF = LDSCTL_OFF + 320, LDS_BYTES = 147456;
constexpr int NWAVES = 8;
constexpr int XL_OFF = RING_BYTES + 1024;
static_assert(XL_OFF + 8192 <= LDS_BYTES, "LDS map");

__constant__ unsigned char BKT[3][132] = {
 {0,1,2,3,4,5,6,7,8,9,10,11,12,13,14,15,16,16,16,16,16,16,17,17,17,17,17,17,17,17,18,18,18,18,18,18,18,18,18,18,19,19,19,19,19,19,19,19,19,19,19,19,19,19,20,20,20,20,20,20,20,20,20,20,20,20,20,20,20,20,20,20,20,21,21,21,21,21,21,21,21,21,21,21,21,21,21,21,21,21,21,21,21,21,21,21,21,21,21,22,22,22,22,22,22,22,22,22,22,22,22,22,22,22,22,22,22,22,22,22,22,22,22,22,22,22,22,22,22,0,0,0},
 {0,4,8,12,16,16,17,17,18,18,19,19,19,19,20,20,20,20,20,21,21,21,21,21,21,22,22,22,22,22,22,22,22,22,23,23,23,23,23,23,23,23,23,23,23,23,24,24,24,24,24,24,24,24,24,24,24,24,24,24,24,24,25,25,25,25,25,25,25,25,25,25,25,25,25,25,25,25,25,25,25,25,25,26,26,26,26,26,26,26,26,26,26,26,26,26,26,26,26,26,26,26,26,26,26,26,26,26,26,26,26,26,26,27,27,27,27,27,27,27,27,27,27,27,27,27,27,27,27,0,0,0},
 {0,16,18,19,20,21,21,22,22,23,23,23,24,24,24,24,25,25,25,25,25,26,26,26,26,26,26,26,26,27,27,27,27,27,27,27,27,27,27,28,28,28,28,28,28,28,28,28,28,28,28,28,29,29,29,29,29,29,29,29,29,29,29,29,29,29,29,29,29,29,30,30,30,30,30,30,30,30,30,30,30,30,30,30,30,30,30,30,30,30,30,30,30,30,30,31,31,31,31,31,31,31,31,31,31,31,31,31,31,31,31,31,31,31,31,31,31,31,31,31,31,31,31,31,31,31,31,31,31,0,0,0}};

namespace pg8 {
constexpr int BM = 256, BK = 64, HALF = 128, HTB = HALF * BK * 2, STAGE_BYTES = 8 * HTB, NXCD = 8, WGM = 8;
__host__ __device__ __forceinline__ int lds_byte(int r, int c) { const int st = (r >> 4) * 2 + (c >> 5), rr = r & 15, cc = c & 31, ob = rr * 64 + cc * 2; return st * 1024 + (ob ^ (((ob >> 9) & 1) << 5)); }
__host__ __device__ __forceinline__ void stage_rc(int b, int& R, int& C) { const int st = b / 1024, sb = b % 1024, swz = sb ^ (((sb >> 9) & 1) << 5); R = (st >> 1) * 16 + swz / 64; C = (st & 1) * 32 + (swz % 64) / 2; }
__host__ __device__ __forceinline__ int perm32(int rho) { const int n = rho >> 4, i = rho & 15; return 8 * (i >> 2) + 4 * n + (i & 3); }

struct Unit { int pm, pn, kind, k0t, nt; };

__device__ __forceinline__ void std_order(int L, int nM, int nN, int& pm, int& pn) {
    const int nwg = nM * nN; int wgid = L;
    { const int q = nwg / NXCD, r = nwg % NXCD, xcd = wgid % NXCD, off = wgid / NXCD; wgid = (xcd < r ? xcd * (q + 1) : r * (q + 1) + (xcd - r) * q) + off; }
    const int nig = WGM * nN, gid = wgid / nig, fm = gid * WGM, gsz = (nM - fm) < WGM ? (nM - fm) : WGM;
    pm = fm + ((wgid % nig) % gsz); pn = (wgid % nig) / gsz;
}
struct SimpleSched {
    static constexpr bool VARB = false;
    const char* A; const char* Bt; int nM, nN, nwg, G, c, ntk; size_t tstep;
    __device__ void init(const void* A_, const void* Bt_, int M, int N, int K, int G_, int c_) { A = (const char*)A_; Bt = (const char*)Bt_; nM = M / BM; nN = N / BM; nwg = nM * nN; G = G_; c = c_; ntk = K / BK; tstep = (size_t)BM * K * 2; }
    __device__ __forceinline__ bool next(int i, Unit& u) const { const int L = i * G + c; if (L >= nwg) return false; std_order(L, nM, nN, u.pm, u.pn); u.kind = 0; u.k0t = 0; u.nt = ntk; return true; }
    __device__ __forceinline__ void addr(const Unit& u, const char*& a, const char*& b, int& bmul) const { a = A + (size_t)u.pm * tstep; b = Bt + (size_t)u.pn * tstep; bmul = 1; }
};
struct DownSched {
    static constexpr bool VARB = false;
    const char* A; const char* Bt; int G, c, S, ntp, ntk; size_t tstep;
    __device__ void init(const void* A_, const void* Bt_, int K, int S_, int G_, int c_) { A = (const char*)A_; Bt = (const char*)Bt_; G = G_; c = c_; S = S_; ntk = K / BK; ntp = ntk / S_; tstep = (size_t)BM * K * 2; }
    __device__ __forceinline__ bool next(int i, Unit& u) const {
        const int L = i * G + c;
        if (L < 256) { std_order(L, 32, 8, u.pm, u.pn); u.kind = 0; u.k0t = 0; u.nt = ntk; return true; }
        const int q = L - 256; if (q >= 8 * S) return false;
        u.pm = 32; u.pn = q & 7; const int s = q >> 3; u.kind = 1 + s; u.k0t = s * ntp; u.nt = ntp; return true;
    }
    __device__ __forceinline__ void addr(const Unit& u, const char*& a, const char*& b, int& bmul) const { a = A + (size_t)u.pm * tstep + (size_t)u.k0t * (BK * 2); b = Bt + (size_t)u.pn * tstep + (size_t)u.k0t * (BK * 2); bmul = 1; }
};
struct PairSched {
    static constexpr bool VARB = false;
    const char* A; const char* Bt; int G, c; size_t tstep;
    __device__ void init(const void* A_, const void* Bt_, int G_, int c_) { A = (const char*)A_; Bt = (const char*)Bt_; G = G_; c = c_; tstep = (size_t)BM * YAW * 2; }
    __device__ __forceinline__ bool next(int i, Unit& u) const {
        const int L = (i >> 1) * G + c; if (L >= 33 * 8) return false;
        std_order(L, 33, 8, u.pm, u.pn); u.kind = i & 1; u.k0t = (i & 1) ? 16 : 0; u.nt = (i & 1) ? 8 : 16; return true;
    }
    __device__ __forceinline__ void addr(const Unit& u, const char*& a, const char*& b, int& bmul) const { a = A + (size_t)u.pm * tstep + (size_t)u.k0t * (BK * 2); b = Bt + (size_t)u.pn * tstep + (size_t)u.k0t * (BK * 2); bmul = 1; }
};
struct MixSched {
    static constexpr bool VARB = true;
    const char* A2; const char* WIN; int G, c; size_t tstep;
    static constexpr int N0 = 33 * 36, N1 = N0 + 6, N2 = N1 + 192;
    __device__ void init(const void* A2_, const void* WIN_, int G_, int c_) { A2 = (const char*)A2_; WIN = (const char*)WIN_; G = G_; c = c_; tstep = (size_t)BM * DM * 2; }
    __device__ __forceinline__ bool next(int i, Unit& u) const {
        const int L = i * G + c; if (L >= N2) return false;
        u.k0t = 0; u.nt = DM / BK;
        if (L < N0) { std_order(L, 33, 36, u.pm, u.pn); u.kind = 0; }
        else if (L < N1) { u.pm = 32; u.pn = 36 + (L - N0); u.kind = 0; }
        else { const int idx = L - N1; u.pm = idx % 6; u.pn = idx / 6; u.kind = 1; }
        return true;
    }
    __device__ __forceinline__ void addr(const Unit& u, const char*& a, const char*& b, int& bmul) const {
        if (u.kind == 0) { a = A2 + (size_t)u.pm * tstep; b = WIN + (size_t)u.pn * tstep; bmul = 1; }
        else { const int g = u.pm >> 1, sh = 2 * g, seg = T >> sh, p0 = u.pn * BM, rr = p0 / seg, j0 = p0 % seg;
               a = WIN + (size_t)(36 + u.pm) * tstep; b = A2 + (size_t)(rr + (j0 << sh)) * (DM * 2); bmul = 1 << sh; }
    }
};

template <class Epi, class Sched>
__device__ __forceinline__ void gemm_phase(LAS unsigned char* lds, const int K, const Sched& S, const Epi& E) {
    const int tid = threadIdx.x, wid = __builtin_amdgcn_readfirstlane(tid >> 6), lane = tid & 63, wr = wid >> 2, wc = wid & 3, fr = lane & 15, fq = lane >> 4;
    unsigned voffA[2], rbk[2], c2[2];
#pragma unroll
    for (int i = 0; i < 2; ++i) { int R, C; stage_rc(tid * 16 + i * 8192, R, C); const int Rb = Epi::PERM ? ((R & ~31) + perm32(R & 31)) : R;
        voffA[i] = (unsigned)(R * K + C) * 2u; rbk[i] = (unsigned)(Rb * K) * 2u; c2[i] = (unsigned)C * 2u; }
    const size_t kstep = (size_t)(BK * 2);
    const size_t hstep = (size_t)HALF * K * 2;
    const unsigned ldsw = (unsigned)wid * 1024u;
    const int aoff = lds_byte(wr * 64 + fr, fq * 8), boff = lds_byte(wc * 32 + fr, fq * 8);
#define PG8_SA(b, h) (((b) * 2 + (h)) * HTB)
#define PG8_SB(b, h) ((4 + (b) * 2 + (h)) * HTB)
#define PG8_STAGE(bufoff, gbase, voff) do { _Pragma("unroll") for (int _i = 0; _i < 2; ++_i) \
        __builtin_amdgcn_global_load_lds((const unsigned*)((const char*)(gbase) + (voff)[_i]), (LAS unsigned*)(lds + (bufoff) + ldsw + _i * 8192), 16, 0, 0); } while (0)
#define PG8_LDA(dst, b, h) do { _Pragma("unroll") for (int m = 0; m < 4; ++m) _Pragma("unroll") for (int k = 0; k < 2; ++k) dst[m][k] = *(const LAS bf16x8*)(lds + PG8_SA(b, h) + aoff + m * 2048 + k * 1024); } while (0)
#define PG8_LDB(dst, b, h) do { _Pragma("unroll") for (int n = 0; n < 2; ++n) _Pragma("unroll") for (int k = 0; k < 2; ++k) dst[n][k] = *(const LAS bf16x8*)(lds + PG8_SB(b, h) + boff + n * 2048 + k * 1024); } while (0)
#define PG8_MMA(ai, bj, At, Bt) do { __builtin_amdgcn_s_setprio(1); _Pragma("unroll") for (int m = 0; m < 4; ++m) _Pragma("unroll") for (int n = 0; n < 2; ++n) _Pragma("unroll") for (int k = 0; k < 2; ++k) \
        acc[ai][bj][m][n] = __builtin_amdgcn_mfma_f32_16x16x32_bf16(Bt[n][k], At[m][k], acc[ai][bj][m][n], 0, 0, 0); __builtin_amdgcn_s_setprio(0); } while (0)
#define PG8_WAIT_V(n) asm volatile("s_waitcnt vmcnt(" #n ")" ::: "memory")
#define PG8_WAIT_L(n) asm volatile("s_waitcnt lgkmcnt(" #n ")" ::: "memory")
#define PG8_BAR __builtin_amdgcn_s_barrier()
#define PG8_SCHED __builtin_amdgcn_sched_barrier(0)
    Unit cur, nxt; int ui = 0;
    if (!S.next(0, cur)) return;
    f32x4 acc[2][2][4][2];
#pragma unroll
    for (int a = 0; a < 2; ++a)
#pragma unroll
        for (int b = 0; b < 2; ++b)
#pragma unroll
            for (int m = 0; m < 4; ++m)
#pragma unroll
                for (int n = 0; n < 2; ++n) acc[a][b][m][n] = (f32x4){0.f, 0.f, 0.f, 0.f};
    bf16x8 At[4][2], B0[2][2], B1[2][2];
    const char* cA; const char* cB; int cmul; S.addr(cur, cA, cB, cmul);
    unsigned cvB[2] = {rbk[0] * (unsigned)cmul + c2[0], rbk[1] * (unsigned)cmul + c2[1]}; size_t chB = hstep * (size_t)cmul;
    PG8_STAGE(PG8_SB(0, 0), cB, cvB); PG8_STAGE(PG8_SB(0, 1), cB + chB, cvB); PG8_STAGE(PG8_SA(0, 0), cA, voffA); PG8_STAGE(PG8_SA(0, 1), cA + hstep, voffA);
    if (wr == 1) PG8_BAR;
    PG8_WAIT_V(2); PG8_BAR;
    PG8_STAGE(PG8_SB(1, 0), cB + kstep, cvB); PG8_STAGE(PG8_SA(1, 0), cA + kstep, voffA); PG8_STAGE(PG8_SB(1, 1), cB + chB + kstep, cvB);
    PG8_WAIT_V(6); PG8_BAR;
    for (;;) {
        const bool has_next = S.next(ui + 1, nxt);
        const char* nA = cA; const char* nB = cB; int nmul = cmul;
        if (has_next) S.addr(nxt, nA, nB, nmul);
        unsigned nvB[2] = {rbk[0] * (unsigned)nmul + c2[0], rbk[1] * (unsigned)nmul + c2[1]}; const size_t nhB = hstep * (size_t)nmul;
        const int nt = cur.nt;
        for (int t = 0; t < nt; t += 2) {
            const bool last = (t == nt - 2);
            const char* a1 = cA + (size_t)(t + 1) * kstep;
            const char* a2 = last ? nA : cA + (size_t)(t + 2) * kstep; const char* b2 = last ? nB : cB + (size_t)(t + 2) * kstep;
            const char* a3 = a2 + kstep; const char* b3 = b2 + kstep;
            unsigned vb[2]; size_t hB;
            if constexpr (Sched::VARB) { vb[0] = last ? nvB[0] : cvB[0]; vb[1] = last ? nvB[1] : cvB[1]; hB = last ? nhB : chB; } else { vb[0] = cvB[0]; vb[1] = cvB[1]; hB = hstep; }
            PG8_LDB(B0, 0, 0); PG8_LDB(B1, 0, 1); PG8_SCHED; PG8_LDA(At, 0, 0); PG8_STAGE(PG8_SA(1, 1), a1 + hstep, voffA);
            PG8_WAIT_V(8); PG8_WAIT_L(0); PG8_BAR; PG8_MMA(0, 0, At, B0); PG8_MMA(0, 1, At, B1); PG8_BAR; PG8_SCHED;
            PG8_LDA(At, 0, 1); PG8_STAGE(PG8_SB(0, 0), b2, vb); PG8_STAGE(PG8_SB(0, 1), b2 + hB, vb); PG8_STAGE(PG8_SA(0, 0), a2, voffA);
            PG8_WAIT_V(8); PG8_WAIT_L(0); PG8_BAR; PG8_MMA(1, 0, At, B0); PG8_MMA(1, 1, At, B1); PG8_BAR; PG8_SCHED;
            PG8_LDB(B0, 1, 0); PG8_LDB(B1, 1, 1); PG8_SCHED; PG8_LDA(At, 1, 0); PG8_STAGE(PG8_SA(0, 1), a2 + hstep, voffA);
            PG8_WAIT_V(8); PG8_WAIT_L(0); PG8_BAR; PG8_MMA(0, 0, At, B0); PG8_MMA(0, 1, At, B1); PG8_BAR; PG8_SCHED;
            PG8_LDA(At, 1, 1); PG8_STAGE(PG8_SB(1, 0), b3, vb); PG8_STAGE(PG8_SB(1, 1), b3 + hB, vb); PG8_STAGE(PG8_SA(1, 0), a3, voffA);
            PG8_WAIT_V(8); PG8_WAIT_L(0); PG8_BAR; PG8_MMA(1, 0, At, B0); PG8_MMA(1, 1, At, B1); PG8_BAR; PG8_SCHED;
        }
        if (wr == 0) PG8_BAR;
        E(acc, cur, wr, wc, fr, fq);
        if (!has_next) break;
        if (!E.keep(cur))
#pragma unroll
        for (int a = 0; a < 2; ++a)
#pragma unroll
            for (int b = 0; b < 2; ++b)
#pragma unroll
                for (int m = 0; m < 4; ++m)
#pragma unroll
                    for (int n = 0; n < 2; ++n) acc[a][b][m][n] = (f32x4){0.f, 0.f, 0.f, 0.f};
        cur = nxt; cA = nA; cB = nB; cmul = nmul; cvB[0] = nvB[0]; cvB[1] = nvB[1]; chB = nhB; ++ui;
        if (wr == 1) PG8_BAR;
    }
    PG8_WAIT_V(0);
    PG8_BAR;
#undef PG8_SA
#undef PG8_SB
#undef PG8_STAGE
#undef PG8_LDA
#undef PG8_LDB
#undef PG8_MMA
#undef PG8_WAIT_V
#undef PG8_WAIT_L
#undef PG8_BAR
#undef PG8_SCHED
}

typedef f32x4 Acc[2][2][4][2];
__device__ __forceinline__ u32x4 pack8(const f32x4 v0, const f32x4 v1) { u32x4 w; w.x = cvt_pk_bf16(v0[0], v0[1]); w.y = cvt_pk_bf16(v0[2], v0[3]); w.z = cvt_pk_bf16(v1[0], v1[1]); w.w = cvt_pk_bf16(v1[2], v1[3]); return w; }

struct EpiSwiglu {
    __device__ __forceinline__ bool keep(const Unit&) const { return false; }
    static constexpr bool PERM = true;
    bf16_t* G;
    __device__ __forceinline__ void operator()(const Acc& acc, const Unit& u, int wr, int wc, int fr, int fq) const {
        const int row0 = u.pm * BM + wr * 64 + fr, col0 = u.pn * HALF + wc * 32 + 8 * fq;
#pragma unroll
        for (int ai = 0; ai < 2; ++ai)
#pragma unroll
            for (int m = 0; m < 4; ++m) {
                const f32x4 a0 = acc[ai][0][m][0], a1 = acc[ai][0][m][1], b0 = acc[ai][1][m][0], b1 = acc[ai][1][m][1];
                const f32x4 g0 = a0 * sigm4(a0) * b0, g1 = a1 * sigm4(a1) * b1;
                *(u32x4*)(G + (size_t)(row0 + ai * HALF + m * 16) * FF + col0) = pack8(g0, g1);
            }
    }
};
struct EpiF32 {
    __device__ __forceinline__ bool keep(const Unit&) const { return false; }
    static constexpr bool PERM = false;
    float* C; float* SL;
    __device__ __forceinline__ void operator()(const Acc& acc, const Unit& u, int wr, int wc, int fr, int fq) const {
        const int col0 = u.pn * BM + wc * 32 + 4 * fq;
        if (u.kind == 0) {
            const int row0 = u.pm * BM + wr * 64 + fr;
#pragma unroll
            for (int ai = 0; ai < 2; ++ai)
#pragma unroll
                for (int m = 0; m < 4; ++m) { float* rowp = C + (size_t)(row0 + ai * HALF + m * 16) * DM + col0;
#pragma unroll
                    for (int bj = 0; bj < 2; ++bj)
#pragma unroll
                        for (int n = 0; n < 2; ++n) *(f32x4*)(rowp + bj * HALF + n * 16) = acc[ai][bj][m][n]; }
        } else {
            float* sl = SL + (size_t)(u.kind - 1) * 128 * DM;
#pragma unroll
            for (int m = 0; m < 4; ++m) { float* rowp = sl + (size_t)(wr * 64 + m * 16 + fr) * DM + col0;
#pragma unroll
                for (int bj = 0; bj < 2; ++bj)
#pragma unroll
                    for (int n = 0; n < 2; ++n) *(f32x4*)(rowp + bj * HALF + n * 16) = acc[0][bj][m][n]; }
        }
    }
};
template <int MODE>
struct EpiDownFused {
    __device__ __forceinline__ bool keep(const Unit&) const { return false; }
    static constexpr bool PERM = true;
    static constexpr int gate_i = (MODE == 1) ? 2 : (MODE == 2 ? 5 : 8), shift_i = (MODE == 1) ? 3 : 6, scale_i = (MODE == 1) ? 4 : 7;
    static constexpr float gsc = (MODE == 2) ? 1.0f : 0.5f;
    float* SL; const float* xin; bf16_t* XR; bf16_t* A; float* out; const float* mod; const float* npost; const float* npre;
    float* xs; unsigned* cnt; LAS unsigned char* xl;
    __device__ __forceinline__ void stats(const Acc& acc, int e, const int upm, const int upn, int wr, int wc, int fr, int fq) const {
        LAS float* P = (LAS float*)xl; LAS float* S = P + 1024; const int tid = threadIdx.x, wid = __builtin_amdgcn_readfirstlane(tid >> 6);
#pragma unroll
        for (int ai = 0; ai < 2; ++ai)
#pragma unroll
            for (int m = 0; m < 4; ++m) { float s = 0.f;
#pragma unroll
                for (int bj = 0; bj < 2; ++bj)
#pragma unroll
                    for (int n = 0; n < 2; ++n) { const f32x4 v = acc[ai][bj][m][n]; s += (v[0] * v[0] + v[1] * v[1]) + (v[2] * v[2] + v[3] * v[3]); }
                s += __shfl_xor(s, 16); s += __shfl_xor(s, 32);
                if (fq == 0) P[(ai * HALF + wr * 64 + m * 16 + fr) * 4 + wc] = s; }
        asm volatile("s_waitcnt lgkmcnt(0)" ::: "memory"); __builtin_amdgcn_s_barrier(); asm volatile("" ::: "memory");
        float* slot = xs + ((size_t)(e * 32 + upm) * 256) * 8; unsigned* c = cnt + (e * 32 + upm) * 64;
        if (tid < 256) { const f32x4 p = *(const LAS f32x4*)(P + tid * 4); __hip_atomic_store(slot + tid * 8 + upn, (p[0] + p[1]) + (p[2] + p[3]), __ATOMIC_RELAXED, __HIP_MEMORY_SCOPE_AGENT); }
        asm volatile("s_waitcnt vmcnt(0)" ::: "memory");
        if (tid < 256 && (tid & 63) == 0) __hip_atomic_fetch_add(c, 1u, __ATOMIC_RELAXED, __HIP_MEMORY_SCOPE_AGENT);
        if (wid == 0) {
            unsigned sp = 0;
            while ((unsigned)__builtin_amdgcn_readfirstlane(__hip_atomic_load(c, __ATOMIC_RELAXED, __HIP_MEMORY_SCOPE_AGENT)) < 32u) { __builtin_amdgcn_s_sleep(2); if (++sp > (1u << 22)) break; }
            __builtin_amdgcn_fence(__ATOMIC_ACQUIRE, "agent");
            asm volatile("s_waitcnt vmcnt(0)" ::: "memory");
        }
        asm volatile("s_waitcnt lgkmcnt(0)" ::: "memory"); __builtin_amdgcn_s_barrier(); asm volatile("" ::: "memory");
        if (tid < 256) { const f32x4 a0 = *(const f32x4*)(slot + tid * 8), a1 = *(const f32x4*)(slot + tid * 8 + 4);
            S[tid] = __builtin_amdgcn_rsqf(((a0[0] + a0[1]) + (a0[2] + a0[3]) + (a1[0] + a1[1]) + (a1[2] + a1[3])) * (1.0f / DM) + EPS); }
        asm volatile("s_waitcnt lgkmcnt(0)" ::: "memory"); __builtin_amdgcn_s_barrier(); asm volatile("" ::: "memory");
    }
    __device__ __forceinline__ void operator()(Acc& acc, const Unit& u, int wr, int wc, int fr, int fq) const {
        const int col0 = u.pn * BM + wc * 32 + 8 * fq;
        if (u.kind != 0) {
            int fr_ = fr; asm volatile("" : "+v"(fr_));
            float* sl = SL + (size_t)(u.kind - 1) * 128 * DM;
#pragma unroll
            for (int m = 0; m < 4; ++m) { float* rowp = sl + (size_t)(wr * 64 + m * 16 + fr_) * DM + col0;
#pragma unroll
                for (int bj = 0; bj < 2; ++bj)
#pragma unroll
                    for (int n = 0; n < 2; ++n) *(f32x4*)(rowp + bj * HALF + n * 4) = acc[0][bj][m][n]; }
            return;
        }
        const LAS float* S = (const LAS float*)xl + 1024;
        const int rl0 = wr * 64 + fr;
        constexpr int NPRE = (MODE == 3) ? 2 : 1;
        u32x4 pre[2][4][2];
        if (MODE != 1) {
#pragma unroll
            for (int ai = 0; ai < NPRE; ++ai)
#pragma unroll
                for (int m = 0; m < 4; ++m)
#pragma unroll
                    for (int bj = 0; bj < 2; ++bj) pre[ai][m][bj] = *(const u32x4*)(XR + (size_t)(u.pm * BM + rl0 + ai * HALF + m * 16) * DM + col0 + bj * HALF);
        }
        stats(acc, 0, u.pm, u.pn, wr, wc, fr, fq);
#pragma unroll
        for (int ai = 0; ai < 2; ++ai)
#pragma unroll
            for (int m = 0; m < 4; ++m) { const int rl = rl0 + ai * HALF + m * 16; const size_t ro = (size_t)(u.pm * BM + rl) * DM; const float rinv = S[rl];
#pragma unroll
                for (int bj = 0; bj < 2; ++bj) { const int c0 = col0 + bj * HALF;
                    f32x4 xo[2];
                    if (MODE == 1) { xo[0] = *(const f32x4*)(xin + ro + c0); xo[1] = *(const f32x4*)(xin + ro + c0 + 4); }
                    else { const u32x4 w = (ai < NPRE) ? pre[ai][m][bj] : *(const u32x4*)(XR + ro + c0);
                        xo[0] = (f32x4){__builtin_bit_cast(float, w.x << 16), __builtin_bit_cast(float, w.x & 0xffff0000u), __builtin_bit_cast(float, w.y << 16), __builtin_bit_cast(float, w.y & 0xffff0000u)};
                        xo[1] = (f32x4){__builtin_bit_cast(float, w.z << 16), __builtin_bit_cast(float, w.z & 0xffff0000u), __builtin_bit_cast(float, w.w << 16), __builtin_bit_cast(float, w.w & 0xffff0000u)}; }
#pragma unroll
                    for (int n = 0; n < 2; ++n) { const int c = c0 + n * 4;
                        const f32x4 gtv = *(const f32x4*)(mod + gate_i * DM + c) * gsc, npv = *(const f32x4*)(npost + c);
                        const f32x4 v = xo[n] + gtv * (acc[ai][bj][m][n] * rinv * npv);
                        acc[ai][bj][m][n] = v;
                        if (MODE == 3) *(f32x4*)(out + O_Y + ro + c) = v; }
                    if (MODE != 3) *(u32x4*)(XR + ro + c0) = pack8(acc[ai][bj][m][0], acc[ai][bj][m][1]); }
                if (m & 1) __builtin_amdgcn_sched_barrier(0); }
        if (MODE == 3) return;
        f32x4 npr[2][2], sc1[2][2], sh[2][2];
#pragma unroll
        for (int bj = 0; bj < 2; ++bj)
#pragma unroll
            for (int n = 0; n < 2; ++n) { const int c = col0 + bj * HALF + n * 4; npr[bj][n] = *(const f32x4*)(npre + c); sc1[bj][n] = *(const f32x4*)(mod + scale_i * DM + c) + 1.0f; sh[bj][n] = *(const f32x4*)(mod + shift_i * DM + c); }
        stats(acc, 1, u.pm, u.pn, wr, wc, fr, fq);
#pragma unroll
        for (int ai = 0; ai < 2; ++ai)
#pragma unroll
            for (int m = 0; m < 4; ++m) { const int rl = rl0 + ai * HALF + m * 16; const size_t ro = (size_t)(u.pm * BM + rl) * DM; const float rinv = S[rl];
#pragma unroll
                for (int bj = 0; bj < 2; ++bj)
#pragma unroll
                    for (int n = 0; n < 2; ++n) { const int c = col0 + bj * HALF + n * 4;
                        const f32x4 h = (acc[ai][bj][m][n] * rinv * npr[bj][n]) * sc1[bj][n] + sh[bj][n];
                        *(u32x2*)(A + ro + c) = (u32x2){cvt_pk_bf16(h[0], h[1]), cvt_pk_bf16(h[2], h[3])}; } }
    }
};
struct EpiMixA {
    __device__ __forceinline__ bool keep(const Unit&) const { return false; }
    static constexpr bool PERM = true;
    float* T1; const bf16_t* SGC;
    __device__ __forceinline__ void operator()(const Acc& acc, const Unit& u, int wr, int wc, int fr, int fq) const {
        const int row0 = u.pm * BM + wr * 64 + fr, col0 = u.pn * BM + wc * 32 + 8 * fq;
#pragma unroll
        for (int ai = 0; ai < 2; ++ai)
#pragma unroll
            for (int m = 0; m < 4; ++m)
#pragma unroll
                for (int bj = 0; bj < 2; ++bj) { const size_t off = (size_t)(row0 + ai * HALF + m * 16) * DM + col0 + bj * HALF;
                    const u32x4 s = *(const u32x4*)(SGC + off);
                    f32x4 g0 = {__builtin_bit_cast(float, s.x << 16), __builtin_bit_cast(float, s.x & 0xffff0000u), __builtin_bit_cast(float, s.y << 16), __builtin_bit_cast(float, s.y & 0xffff0000u)};
                    f32x4 g1 = {__builtin_bit_cast(float, s.z << 16), __builtin_bit_cast(float, s.z & 0xffff0000u), __builtin_bit_cast(float, s.w << 16), __builtin_bit_cast(float, s.w & 0xffff0000u)};
                    *(f32x4*)(T1 + off) = acc[ai][bj][m][0] * g0; *(f32x4*)(T1 + off + 4) = acc[ai][bj][m][1] * g1; }
    }
};
struct EpiMixB {
    __device__ __forceinline__ bool keep(const Unit&) const { return false; }
    static constexpr bool PERM = true;
    const float* T1; const bf16_t* SGA; bf16_t* MG;
    __device__ __forceinline__ void operator()(const Acc& acc, const Unit& u, int wr, int wc, int fr, int fq) const {
        const int row0 = u.pm * BM + wr * 64 + fr, col0 = u.pn * BM + wc * 32 + 8 * fq;
#pragma unroll
        for (int ai = 0; ai < 2; ++ai)
#pragma unroll
            for (int m = 0; m < 4; ++m)
#pragma unroll
                for (int bj = 0; bj < 2; ++bj) { const size_t off = (size_t)(row0 + ai * HALF + m * 16) * DM + col0 + bj * HALF;
                    const u32x4 s = *(const u32x4*)(SGA + off);
                    f32x4 g0 = {__builtin_bit_cast(float, s.x << 16), __builtin_bit_cast(float, s.x & 0xffff0000u), __builtin_bit_cast(float, s.y << 16), __builtin_bit_cast(float, s.y & 0xffff0000u)};
                    f32x4 g1 = {__builtin_bit_cast(float, s.z << 16), __builtin_bit_cast(float, s.z & 0xffff0000u), __builtin_bit_cast(float, s.w << 16), __builtin_bit_cast(float, s.w & 0xffff0000u)};
                    const f32x4 t0 = *(const f32x4*)(T1 + off), t1 = *(const f32x4*)(T1 + off + 4);
                    *(u32x4*)(MG + off) = pack8(t0 + acc[ai][bj][m][0] * g0, t1 + acc[ai][bj][m][1] * g1); }
    }
};
struct EpiMixPair {
    static constexpr bool PERM = true;
    const bf16_t* RT; const bf16_t* SGA; bf16_t* MG;
    __device__ __forceinline__ bool keep(const Unit& u) const { return u.kind == 0; }
    __device__ __forceinline__ void operator()(Acc& acc, const Unit& u, int wr, int wc, int fr, int fq) const {
        const int row0 = u.pm * BM + wr * 64 + fr, col0 = u.pn * BM + wc * 32 + 8 * fq;
        const bf16_t* G = (u.kind == 0) ? RT : SGA;
        u32x4 s[2][4][2];
#pragma unroll
        for (int ai = 0; ai < 2; ++ai)
#pragma unroll
            for (int m = 0; m < 4; ++m)
#pragma unroll
                for (int bj = 0; bj < 2; ++bj) s[ai][m][bj] = *(const u32x4*)(G + (size_t)(row0 + ai * HALF + m * 16) * DM + col0 + bj * HALF);
#pragma unroll
        for (int ai = 0; ai < 2; ++ai)
#pragma unroll
            for (int m = 0; m < 4; ++m)
#pragma unroll
                for (int bj = 0; bj < 2; ++bj) { const u32x4 w = s[ai][m][bj];
                    const f32x4 g0 = {__builtin_bit_cast(float, w.x << 16), __builtin_bit_cast(float, w.x & 0xffff0000u), __builtin_bit_cast(float, w.y << 16), __builtin_bit_cast(float, w.y & 0xffff0000u)};
                    const f32x4 g1 = {__builtin_bit_cast(float, w.z << 16), __builtin_bit_cast(float, w.z & 0xffff0000u), __builtin_bit_cast(float, w.w << 16), __builtin_bit_cast(float, w.w & 0xffff0000u)};
                    acc[ai][bj][m][0] *= g0; acc[ai][bj][m][1] *= g1;
                    if (u.kind == 1) *(u32x4*)(MG + (size_t)(row0 + ai * HALF + m * 16) * DM + col0 + bj * HALF) = pack8(acc[ai][bj][m][0], acc[ai][bj][m][1]); }
    }
};
struct EpiMixIn {
    __device__ __forceinline__ bool keep(const Unit&) const { return false; }
    static constexpr bool PERM = true;
    bf16_t* U; bf16_t* QN; bf16_t* KN; bf16_t* VT; bf16_t* SGC; bf16_t* SGA; float* out;
    __device__ __forceinline__ void operator()(const Acc& acc, const Unit& u, int wr, int wc, int fr, int fq) const {
        const int rbase = u.pm * BM + wr * 64 + fr, cin = wc * 32 + 8 * fq;
        if (u.kind == 1) {
            const int g = u.pm >> 1, sh = 2 * g, seg = T >> sh, W = 128 << sh;
            const int p0 = u.pn * BM, rr = p0 / seg, j0 = p0 % seg;
            const bool has_pv = (rr + ((j0 + 255) << sh)) >= T - W;
            float* pv = out + o_pv(g);
#pragma unroll
            for (int ai = 0; ai < 2; ++ai)
#pragma unroll
                for (int m = 0; m < 4; ++m) { const int vc = rbase + ai * HALF + m * 16;
#pragma unroll
                    for (int bj = 0; bj < 2; ++bj) { const int pl = bj * HALF + cin;
                        {
                            const int hh = (vc >> 7) & 3, dt = (vc & 127) >> 4, tt = ((j0 + pl) >> 4), kg = 2 * (fq & 1);
                            bf16_t* vb = VT + (size_t)(g * 4 + hh) * (T * 128) + ((size_t)((rr * (seg >> 4) + tt) * 8 + dt)) * 256 + (vc & 15) * 4;
                            *(u32x2*)(vb + (kg * 16) * 4) = (u32x2){cvt_pk_bf16(acc[ai][bj][m][0][0], acc[ai][bj][m][0][1]), cvt_pk_bf16(acc[ai][bj][m][0][2], acc[ai][bj][m][0][3])};
                            *(u32x2*)(vb + ((kg + 1) * 16) * 4) = (u32x2){cvt_pk_bf16(acc[ai][bj][m][1][0], acc[ai][bj][m][1][1]), cvt_pk_bf16(acc[ai][bj][m][1][2], acc[ai][bj][m][1][3])}; }
                        if (has_pv) {
#pragma unroll
                            for (int n = 0; n < 2; ++n)
#pragma unroll
                                for (int i = 0; i < 4; ++i) { const int t = rr + ((j0 + pl + 4 * n + i) << sh);
                                    if (t >= T - W) pv[(size_t)(t - (T - W)) * 512 + (vc & 511)] = acc[ai][bj][m][n][i]; }
                        } } }
            return;
        }
        const int pn = u.pn;
        if (pn < 8) {
            const int col = pn * HALF + cin;
#pragma unroll
            for (int ai = 0; ai < 2; ++ai)
#pragma unroll
                for (int m = 0; m < 4; ++m) { const int r = rbase + ai * HALF + m * 16;
                    const f32x4 u0 = acc[ai][0][m][0] * sigm4(acc[ai][1][m][0]), u1 = acc[ai][0][m][1] * sigm4(acc[ai][1][m][1]);
                    *(u32x4*)(U + (size_t)r * CC + col) = pack8(u0, u1);
                    if (r >= T - 30 && r < T) { float* o = out + O_PCONV + (size_t)(r - (T - 30)) * CC + col; *(f32x4*)o = u0; *(f32x4*)(o + 4) = u1; }
                    else if (r >= T && r < MTOK) { const int b = (r - T) >> 2, j = (r - T) & 3; float* o = out + O_SCONV + (size_t)(b * 30 + 26 + j) * CC + col; *(f32x4*)o = u0; *(f32x4*)(o + 4) = u1; } }
        } else if (pn < 14) {
            const int col = (pn - 8) * BM + cin;
#pragma unroll
            for (int ai = 0; ai < 2; ++ai)
#pragma unroll
                for (int m = 0; m < 4; ++m) { const int r = rbase + ai * HALF + m * 16;
#pragma unroll
                    for (int bj = 0; bj < 2; ++bj) *(u32x4*)(QN + (size_t)r * AW + col + bj * HALF) = pack8(acc[ai][bj][m][0] * QSCALE, acc[ai][bj][m][1] * QSCALE); }
        } else if (pn < 20) {
            const int ct = pn - 14, g = ct >> 1, sh = 2 * g, W = 128 << sh, col = ct * BM + cin;
            float* pk = out + o_pk(g); float* sk = out + o_sk(g);
#pragma unroll
            for (int ai = 0; ai < 2; ++ai)
#pragma unroll
                for (int m = 0; m < 4; ++m) { const int r = rbase + ai * HALF + m * 16;
#pragma unroll
                    for (int bj = 0; bj < 2; ++bj) { const int hc = (ct & 1) * BM + bj * HALF + cin;
                        if (r < T) { const int rr = r & ((1 << sh) - 1), jj = r >> sh, hh = 2 * (ct & 1) + bj;
                            *(u32x4*)(KN + (size_t)(g * 4 + hh) * (T * 128) + ((size_t)((rr * ((T >> sh) >> 4) + (jj >> 4)) * 4 + wc)) * 512 + (fq * 16 + (jj & 15)) * 8) = pack8(acc[ai][bj][m][0], acc[ai][bj][m][1]); }
                        if (r < T) { if (r >= T - W) { float* o = pk + (size_t)(r - (T - W)) * 512 + hc; *(f32x4*)o = acc[ai][bj][m][0]; *(f32x4*)(o + 4) = acc[ai][bj][m][1]; } }
                        else if (r < MTOK) { const int b = (r - T) >> 2, j = (r - T) & 3; float* o = sk + ((size_t)b * W + (W - 4 + j)) * 512 + hc; *(f32x4*)o = acc[ai][bj][m][0]; *(f32x4*)(o + 4) = acc[ai][bj][m][1]; } } }
        } else if (pn < 36) {
            const int col = (pn - 20) * HALF + cin;
#pragma unroll
            for (int ai = 0; ai < 2; ++ai)
#pragma unroll
                for (int m = 0; m < 4; ++m) { const size_t off = (size_t)(rbase + ai * HALF + m * 16) * DM + col;
                    const f32x4 a0 = sigm4(acc[ai][1][m][0]), a1 = sigm4(acc[ai][1][m][1]);
                    const f32x4 e0 = {ex2(-LOG2E * acc[ai][1][m][0][0]), ex2(-LOG2E * acc[ai][1][m][0][1]), ex2(-LOG2E * acc[ai][1][m][0][2]), ex2(-LOG2E * acc[ai][1][m][0][3])};
                    const f32x4 e1 = {ex2(-LOG2E * acc[ai][1][m][1][0]), ex2(-LOG2E * acc[ai][1][m][1][1]), ex2(-LOG2E * acc[ai][1][m][1][2]), ex2(-LOG2E * acc[ai][1][m][1][3])};
                    *(u32x4*)(SGC + off) = pack8(sigm4(acc[ai][0][m][0]) * (e0 + 1.0f), sigm4(acc[ai][0][m][1]) * (e1 + 1.0f));
                    *(u32x4*)(SGA + off) = pack8(a0, a1); }
        } else {
            const int ct = pn - 36, g = ct >> 1, sh = 2 * g, W = 128 << sh;
            float* sv = out + o_sv(g);
#pragma unroll
            for (int ai = 0; ai < 2; ++ai)
#pragma unroll
                for (int m = 0; m < 4; ++m) { const int r = rbase + ai * HALF + m * 16;
                    if (r >= T && r < MTOK) { const int b = (r - T) >> 2, j = (r - T) & 3;
#pragma unroll
                        for (int bj = 0; bj < 2; ++bj) { const int hc = (ct & 1) * BM + bj * HALF + cin; float* o = sv + ((size_t)b * W + (W - 4 + j)) * 512 + hc; *(f32x4*)o = acc[ai][bj][m][0]; *(f32x4*)(o + 4) = acc[ai][bj][m][1]; } } }
        }
    }
};
}

#define RLX_AGENT __ATOMIC_RELAXED, __HIP_MEMORY_SCOPE_AGENT
#define XB_TMO      128
#define XB_XCNT(j)  (256  + 64 * (j))
#define XB_XSUB(j)  (1280 + 64 * (j))
#define XB_XGEN(j)  (2304 + 64 * (j))
#define XB_TOP      3328
#define XB_TOPGEN   3392
#define XCD_BAR_WORDS 3456
#define XB_SPIN_CAP (1u << 18)
__device__ __forceinline__ unsigned xb_ld(unsigned* p)              { return __hip_atomic_load(p, __ATOMIC_RELAXED, __HIP_MEMORY_SCOPE_AGENT); }
__device__ __forceinline__ unsigned xb_add(unsigned* p, unsigned v) { return __hip_atomic_fetch_add(p, v, __ATOMIC_RELAXED, __HIP_MEMORY_SCOPE_AGENT); }
__device__ __forceinline__ unsigned xb_xcc_id() { return (unsigned)__builtin_amdgcn_s_getreg((3 << 11) | 20) & 0xFu; }
#define XB_SPIN(cond, bar) do { unsigned _sp = 0; while (cond) { __builtin_amdgcn_s_sleep(1); \
    if ((++_sp & 255u) == 0u) { if (xb_ld(&(bar)[XB_TMO])) break; if (_sp > XB_SPIN_CAP) { atomicAdd(&(bar)[XB_TMO], 1u); break; } } } } while (0)
struct XcdBarrier { unsigned* bar; unsigned x; volatile LAS unsigned* st; };
__device__ __forceinline__ XcdBarrier xcd_barrier_post(unsigned* bar, volatile LAS unsigned* st) {
    XcdBarrier b; b.bar = bar; b.x = xb_xcc_id(); b.st = st;
    if (threadIdx.x == 0) (void)xb_add(&bar[XB_XCNT(b.x)], 1u);
    return b;
}
__device__ __forceinline__ void xcd_barrier_complete(unsigned* bar, unsigned x, unsigned& nloc, unsigned& nx) {
    const unsigned G = gridDim.x * gridDim.y * gridDim.z;
    unsigned sum, cnt, mine, sp = 0u;
    for (;;) {
        sum = 0u; cnt = 0u; mine = 0u;
#pragma unroll
        for (unsigned j = 0; j < 16; ++j) { const unsigned c = xb_ld(&bar[XB_XCNT(j)]); sum += c; cnt += (c > 0u) ? 1u : 0u; mine = (j == x) ? c : mine; }
        if (sum == G) break;
        __builtin_amdgcn_s_sleep(1);
        if ((++sp & 255u) == 0u) { if (xb_ld(&bar[XB_TMO])) break; if (sp > XB_SPIN_CAP) { atomicAdd(&bar[XB_TMO], 1u); break; } }
    }
    nloc = mine > 0u ? mine : 1u; nx = cnt > 0u ? cnt : 1u;
}
__device__ __forceinline__ void xcd_barrier(const XcdBarrier& b, bool nowait = false) {
    asm volatile("s_waitcnt vmcnt(0)" ::: "memory");
    __syncthreads();
    if (threadIdx.x == 0) {
        unsigned* bar = b.bar;
        __builtin_amdgcn_s_waitcnt(0);
        unsigned nloc = b.st[0], nx = b.st[1];
        if (nloc == 0u) { xcd_barrier_complete(bar, b.x, nloc, nx); b.st[0] = nloc; b.st[1] = nx; }
        const unsigned old = xb_add(&bar[XB_XSUB(b.x)], 1u);
        const unsigned gen = old / nloc;
        if (old + 1u == (gen + 1u) * nloc) {
            __builtin_amdgcn_fence(__ATOMIC_RELEASE, "agent");
            asm volatile("s_waitcnt vmcnt(0)" ::: "memory");
            const unsigned og = xb_add(&bar[XB_TOP], 1u);
            const unsigned tg = og / nx;
            if (og + 1u == (tg + 1u) * nx) xb_add(&bar[XB_TOPGEN], 1u);
            else XB_SPIN(xb_ld(&bar[XB_TOPGEN]) == tg, bar);
            __builtin_amdgcn_fence(__ATOMIC_ACQUIRE, "agent");
            xb_add(&bar[XB_XGEN(b.x)], 1u);
            asm volatile("s_waitcnt vmcnt(0)" ::: "memory");
        } else if (!nowait) {
            XB_SPIN(xb_ld(&bar[XB_XGEN(b.x)]) == gen, bar);
            __builtin_amdgcn_fence(__ATOMIC_ACQUIRE, "agent");
            asm volatile("s_waitcnt vmcnt(0)" ::: "memory");
        }
    }
    __syncthreads();
}

struct Args {
    const float* in[34]; float* out; unsigned char* ws; int ph_lo, ph_hi, li, pad;
};
enum { I_XP = 0, I_XS, I_CK0, I_CV0, I_CK1, I_CV1, I_CK2, I_CV2, I_STC, I_CP, I_CS, I_WADA, I_BADA, I_F1NPRE, I_F1NPOST, I_F1W1, I_F1W3, I_F1W2, I_MNPRE, I_MNPOST, I_WIN, I_DWK, I_DWB, I_LNG, I_LNB,
       I_WCO, I_WAO, I_WOUT, I_RELB, I_F2NPRE, I_F2NPOST, I_F2W1, I_F2W3, I_F2W2 };

#define LDS_WAIT() asm volatile("s_waitcnt lgkmcnt(0)" ::: "memory")

__device__ __forceinline__ u32x4 pack8_(const f32x4 v0, const f32x4 v1) { return pg8::pack8(v0, v1); }
__device__ __forceinline__ void p0_transpose_item(const float* __restrict__ W, int K, int N, bf16_t* WT, int mode, LAS float* scr, int item, int lane, int ldk = 0, int koff = 0) {
    if (ldk == 0) ldk = K;
    const int nblk = N / 32, kb = item / nblk, nb = item % nblk, k0 = 64 * kb, n0 = 32 * nb;
#pragma unroll 8
    for (int i = 0; i < 32; ++i) { const int kk = 2 * i + (lane >> 5); scr[kk * 33 + (lane & 31)] = W[(size_t)(k0 + kk) * N + n0 + (lane & 31)]; }
    LDS_WAIT(); asm volatile("" ::: "memory");
    int r0;
    if (mode == 0) r0 = n0;
    else if (mode == 1) r0 = 256 * (n0 >> 7) + (n0 & 127);
    else if (mode == 2) r0 = 256 * (n0 >> 7) + 128 + (n0 & 127);
    else {
        if (n0 < 1024) r0 = 256 * (n0 >> 7) + (n0 & 127);
        else if (n0 < 2048) { const int n = n0 - 1024; r0 = 256 * (n >> 7) + 128 + (n & 127); }
        else if (n0 < 5120) r0 = n0;
        else if (n0 < 6656) r0 = 9216 + (n0 - 5120);
        else if (n0 < 8704) { const int n = n0 - 6656; r0 = 5120 + 256 * (n >> 7) + (n & 127); }
        else { const int n = n0 - 8704; r0 = 5120 + 256 * (n >> 7) + 128 + (n & 127); }
    }
    const int c = lane & 7;
#pragma unroll
    for (int j = 0; j < 4; ++j) { const int n = (lane >> 3) + 8 * j; const LAS float* s = scr + (8 * c) * 33 + n;
        u32x4 o; o.x = cvt_pk_bf16(s[0 * 33], s[1 * 33]); o.y = cvt_pk_bf16(s[2 * 33], s[3 * 33]); o.z = cvt_pk_bf16(s[4 * 33], s[5 * 33]); o.w = cvt_pk_bf16(s[6 * 33], s[7 * 33]);
        *(u32x4*)(WT + (size_t)(r0 + n) * ldk + koff + k0 + 8 * c) = o; }
    LDS_WAIT(); asm volatile("" ::: "memory");
}

typedef float f32x16 __attribute__((ext_vector_type(16)));
__device__ __forceinline__ void p0_adaln(const Args& a, LAS unsigned char* lds, int vcu, int G, int tid, int wid, int lane) {
    const float* __restrict__ wada = a.in[I_WADA]; const float* __restrict__ cp = a.in[I_CP]; const float* __restrict__ cs = a.in[I_CS];
    float* MOD = (float*)(a.ws + WS_MOD);
    LAS float* scp = (LAS float*)lds;
    LAS float* red = (LAS float*)(lds + 8192);
    for (int k = tid; k < DM; k += 512) { const float v = cp[k]; scp[k] = v * sigm(v); }
    const int bl = lane & 31, h = lane >> 5, kw = wid * 256;
    bf16x8 af[16];
#pragma unroll
    for (int s = 0; s < 16; ++s) { const float* p = cs + (size_t)bl * DM + kw + 16 * s + 8 * h; const f32x4 v0 = *(const f32x4*)p, v1 = *(const f32x4*)(p + 4);
        af[s] = __builtin_bit_cast(bf16x8, pack8_(v0 * sigm4(v0), v1 * sigm4(v1))); }
    __syncthreads();
    for (int tile = vcu; tile < NMODW / 32; tile += G) {
        const int n0 = tile * 32;
        f32x16 acc;
#pragma unroll
        for (int q = 0; q < 16; ++q) acc[q] = 0.f;
        float accp = 0.f;
        const float* wp = wada + (size_t)(kw + 8 * h) * NMODW + n0 + bl;
#pragma unroll
        for (int sb = 0; sb < 16; sb += 4) {
            float wv[4][8];
#pragma unroll
            for (int t = 0; t < 4; ++t)
#pragma unroll
                for (int j = 0; j < 8; ++j) wv[t][j] = __builtin_nontemporal_load(wp + (size_t)(16 * (sb + t) + j) * NMODW);
            __builtin_amdgcn_sched_barrier(0);
#pragma unroll
            for (int t = 0; t < 4; ++t) {
                const int s = sb + t;
                u32x4 bw; bw.x = cvt_pk_bf16(wv[t][0], wv[t][1]); bw.y = cvt_pk_bf16(wv[t][2], wv[t][3]); bw.z = cvt_pk_bf16(wv[t][4], wv[t][5]); bw.w = cvt_pk_bf16(wv[t][6], wv[t][7]);
                acc = __builtin_amdgcn_mfma_f32_32x32x16_bf16(af[s], __builtin_bit_cast(bf16x8, bw), acc, 0, 0, 0);
                const LAS f32x4* sp = (const LAS f32x4*)(scp + kw + 16 * s + 8 * h); const f32x4 p0 = sp[0], p1 = sp[1];
                accp += (p0[0] * wv[t][0] + p0[1] * wv[t][1]) + (p0[2] * wv[t][2] + p0[3] * wv[t][3]) + (p1[0] * wv[t][4] + p1[1] * wv[t][5]) + (p1[2] * wv[t][6] + p1[3] * wv[t][7]);
            }
            __builtin_amdgcn_sched_barrier(0);
        }
        accp += __shfl_xor(accp, 32);
#pragma unroll
        for (int q = 0; q < 16; ++q) red[(wid * 33 + (q & 3) + 8 * (q >> 2) + 4 * h) * 32 + bl] = acc[q];
        if (h == 0) red[(wid * 33 + 32) * 32 + bl] = accp;
        __syncthreads();
        for (int o = tid; o < 33 * 32; o += 512) { const int b = o >> 5, col = o & 31; float s = a.in[I_BADA][n0 + col];
#pragma unroll
            for (int w8 = 0; w8 < 8; ++w8) s += red[(w8 * 33 + b) * 32 + col];
            MOD[(size_t)(b == 32 ? 0 : b + 1) * NMODW + n0 + col] = s; }
        __syncthreads();
    }
}

constexpr int CP_N0 = 2 * 32 * 31, CP_N1 = 2 * 32 * 127, CP_N2 = 2 * 32 * 511, CP_NCHUNK = CP_N0 + CP_N1 + CP_N2;
__device__ __forceinline__ void p0_copy_chunk(const Args& a, int ci, int lane) {
    int g, per, r = ci;
    if (r < CP_N0) { g = 0; per = 31; } else { r -= CP_N0; if (r < CP_N1) { g = 1; per = 127; } else { r -= CP_N1; g = 2; per = 511; } }
    const int kvb = r / per, ch = r % per, kv = kvb >> 5, b = kvb & 31, W = 128 << (2 * g);
    const float* srcb = (g == 0 ? (kv ? a.in[I_CV0] : a.in[I_CK0]) : g == 1 ? (kv ? a.in[I_CV1] : a.in[I_CK1]) : (kv ? a.in[I_CV2] : a.in[I_CK2]));
    const f32x4* src = (const f32x4*)(srcb + ((size_t)b * W + 4) * 512) + (size_t)ch * 512 + lane;
    f32x4* dst = (f32x4*)(a.out + (kv ? o_sv(g) : o_sk(g)) + (size_t)b * W * 512) + (size_t)ch * 512 + lane;
    f32x4 v[8];
#pragma unroll
    for (int q = 0; q < 8; ++q) v[q] = __builtin_nontemporal_load(src + 64 * q);
#pragma unroll
    for (int q = 0; q < 8; ++q) __builtin_nontemporal_store(v[q], dst + 64 * q);
}

#ifndef FILL_UP
#define FILL_UP 5
#define FILL_7A 1
#define FILL_7B 1
#define FILL_8 1
#endif
constexpr int CPJ_CHUNKS = 16, CP_NJOBS = CP_NCHUNK / CPJ_CHUNKS, CW_QC = 128;
static_assert(CP_NCHUNK % CPJ_CHUNKS == 0, "copy jobs");
__device__ __forceinline__ void copy_filler(const Args& a, LAS unsigned char* lds, int tid, int wid, int lane, int maxjobs) {
    volatile LAS int* slot = (volatile LAS int*)(lds + MISC_OFF + 64);
    unsigned* ctr = (unsigned*)(a.ws + WS_CTL) + CW_QC;
    for (int it = 0; it < maxjobs; ++it) {
        if (tid == 0) slot[it & 1] = (int)__hip_atomic_fetch_add(ctr, 1u, __ATOMIC_RELAXED, __HIP_MEMORY_SCOPE_AGENT);
        __syncthreads();
        const int job = slot[it & 1];
        if (job >= CP_NJOBS) break;
        p0_copy_chunk(a, job * CPJ_CHUNKS + 2 * wid, lane); p0_copy_chunk(a, job * CPJ_CHUNKS + 2 * wid + 1, lane);
    }
    __syncthreads();
}
__device__ __forceinline__ void p0_weights(const Args& a, LAS unsigned char* lds, int vcu, int G, int tid, int wid, int lane) {
    {
        LAS float* scr = (LAS float*)(lds + wid * 16384);
        const int gw = vcu * NWAVES + wid, NGW = G * NWAVES;
        constexpr int I_UP = (DM / 64) * (FF / 32), I_DN = (FF / 64) * (DM / 32), I_IN = (DM / 64) * (10752 / 32), I_CO = (CC / 64) * (DM / 32), I_AO = (512 / 64) * (DM / 32), I_OUT = (DM / 64) * (DM / 32);
        constexpr int NITEMS = 4 * I_UP + 2 * I_DN + I_IN + I_CO + I_AO + I_OUT;
        unsigned char* ws = a.ws;
        for (int it = gw; it < NITEMS; it += NGW) {
            int r = it;
            if (r < I_UP) { p0_transpose_item(a.in[I_F1W1], DM, FF, (bf16_t*)(ws + WS_W13A), 1, scr, r, lane); continue; } r -= I_UP;
            if (r < I_UP) { p0_transpose_item(a.in[I_F1W3], DM, FF, (bf16_t*)(ws + WS_W13A), 2, scr, r, lane); continue; } r -= I_UP;
            if (r < I_DN) { p0_transpose_item(a.in[I_F1W2], FF, DM, (bf16_t*)(ws + WS_W2A), 0, scr, r, lane); continue; } r -= I_DN;
            if (r < I_IN) { p0_transpose_item(a.in[I_WIN], DM, 10752, (bf16_t*)(ws + WS_WIN), 3, scr, r, lane); continue; } r -= I_IN;
            if (r < I_CO) { p0_transpose_item(a.in[I_WCO], CC, DM, (bf16_t*)(ws + WS_WCO), 0, scr, r, lane, YAW, 0); continue; } r -= I_CO;
            if (r < I_AO) { p0_transpose_item(a.in[I_WAO], 512, DM, (bf16_t*)(ws + WS_WCO), 0, scr, r, lane, YAW, CC); continue; } r -= I_AO;
            if (r < I_OUT) { p0_transpose_item(a.in[I_WOUT], DM, DM, (bf16_t*)(ws + WS_WOUT), 0, scr, r, lane); continue; } r -= I_OUT;
            if (r < I_UP) { p0_transpose_item(a.in[I_F2W1], DM, FF, (bf16_t*)(ws + WS_W13B), 1, scr, r, lane); continue; } r -= I_UP;
            if (r < I_UP) { p0_transpose_item(a.in[I_F2W3], DM, FF, (bf16_t*)(ws + WS_W13B), 2, scr, r, lane); continue; } r -= I_UP;
            p0_transpose_item(a.in[I_F2W2], FF, DM, (bf16_t*)(ws + WS_W2B), 0, scr, r, lane);
        }
    }
    {
        const int gw = vcu * NWAVES + wid, NGW = G * NWAVES;
        for (int row = gw; row < 32 * 26; row += NGW) { const int b = row / 26, i = row % 26;
            const f32x4* src = (const f32x4*)(a.in[I_STC] + ((size_t)b * 30 + i + 4) * CC); f32x4* dst = (f32x4*)(a.out + O_SCONV + ((size_t)b * 30 + i) * CC);
#pragma unroll
            for (int q = 0; q < 4; ++q) dst[lane + 64 * q] = src[lane + 64 * q]; }
    }
}

template <int MODE, int NSLAB, bool SAMPLE_ONLY = false>
__device__ __forceinline__ void row_pass(const Args& a, int vcu, int G, int wid, int lane, const float* npost, int gate_i, float gsc, const float* npre, int shift_i, int scale_i) {
    const float* MOD = (const float*)(a.ws + WS_MOD);
    float* XR = (float*)(a.ws + WS_XR); const float* F = (const float*)(a.ws + WS_F); bf16_t* A = (bf16_t*)(a.ws + WS_A);
    const int gw = vcu * NWAVES + wid, NGW = G * NWAVES;
    for (int it = gw; it < (SAMPLE_ONLY ? MP - T : MP); it += NGW) {
        const int r = (it < NS) ? T + it : (it < MP - T ? MTOK + (it - NS) : it - (MP - T));
        if (r >= MTOK) {
            if (MODE != 3) {
#pragma unroll
                for (int j = 0; j < 8; ++j) *(u32x2*)(A + (size_t)r * DM + 4 * lane + 256 * j) = (u32x2){0u, 0u}; }
            continue;
        }
        const float* mod = MOD + (size_t)(r < T ? 0 : 1 + ((r - T) >> 2)) * NMODW;
        const float* xin = (r < T) ? a.in[I_XP] + (size_t)r * DM : a.in[I_XS] + (size_t)(r - T) * DM;
        f32x4 x[8];
        if (MODE == 0) {
#pragma unroll
            for (int j = 0; j < 8; ++j) x[j] = *(const f32x4*)(xin + 4 * lane + 256 * j);
        } else {
            f32x4 f[8], xo[8], gt[8], np[8];
            if (r >= T) {
#pragma unroll
                for (int jb = 0; jb < 8; ++jb) {
                    f32x4 sv[NSLAB > 0 ? NSLAB : 1];
                    const float* sl = (const float*)(a.ws + WS_SL) + (size_t)(r - T) * DM + 4 * lane + 256 * jb;
#pragma unroll
                    for (int q = 0; q < NSLAB; ++q) sv[q] = *(const f32x4*)(sl + (size_t)q * 128 * DM);
                    f32x4 s = sv[0];
#pragma unroll
                    for (int q = 1; q < NSLAB; ++q) s += sv[q];
                    f[jb] = s;
                    __builtin_amdgcn_sched_barrier(0);
                }
            }
#pragma unroll
            for (int j = 0; j < 8; ++j) { const int c = 4 * lane + 256 * j;
                if (r < T) f[j] = *(const f32x4*)(F + (size_t)r * DM + c);
                xo[j] = (MODE == 1) ? *(const f32x4*)(xin + c) : *(const f32x4*)(XR + (size_t)r * DM + c);
                gt[j] = *(const f32x4*)(mod + gate_i * DM + c); np[j] = *(const f32x4*)(npost + c); }
            float ss = 0.f;
#pragma unroll
            for (int j = 0; j < 8; ++j) ss += (f[j][0] * f[j][0] + f[j][1] * f[j][1]) + (f[j][2] * f[j][2] + f[j][3] * f[j][3]);
            const float rinv = __builtin_amdgcn_rsqf(wave_sum(ss) * (1.0f / DM) + EPS) * gsc;
#pragma unroll
            for (int j = 0; j < 8; ++j) { const int c = 4 * lane + 256 * j;
                x[j] = xo[j] + gt[j] * (f[j] * rinv * np[j]);
                if (MODE == 3) *(f32x4*)(a.out + O_Y + (size_t)r * DM + c) = x[j]; else *(f32x4*)(XR + (size_t)r * DM + c) = x[j]; }
        }
        if (MODE != 3) {
            f32x4 npr[8], sc[8], sh[8];
#pragma unroll
            for (int j = 0; j < 8; ++j) { const int c = 4 * lane + 256 * j; npr[j] = *(const f32x4*)(npre + c); sc[j] = *(const f32x4*)(mod + scale_i * DM + c); sh[j] = *(const f32x4*)(mod + shift_i * DM + c); }
            float ss = 0.f;
#pragma unroll
            for (int j = 0; j < 8; ++j) ss += (x[j][0] * x[j][0] + x[j][1] * x[j][1]) + (x[j][2] * x[j][2] + x[j][3] * x[j][3]);
            const float rinv = __builtin_amdgcn_rsqf(wave_sum(ss) * (1.0f / DM) + EPS);
#pragma unroll
            for (int j = 0; j < 8; ++j) { const int c = 4 * lane + 256 * j;
                const f32x4 h = (x[j] * rinv * npr[j]) * (sc[j] + 1.0f) + sh[j];
                *(u32x2*)(A + (size_t)r * DM + c) = (u32x2){cvt_pk_bf16(h[0], h[1]), cvt_pk_bf16(h[2], h[3])}; }
        }
    }
}

template <int MODE, int NSLAB>
__device__ __forceinline__ void sample_rows(const Args& a, LAS unsigned char* lds, int vcu, int G, int tid, int wid, int lane, const float* npost, int gate_i, float gsc, const float* npre, int shift_i, int scale_i) {
    const float* MOD = (const float*)(a.ws + WS_MOD);
    bf16_t* XR = (bf16_t*)(a.ws + WS_XR); bf16_t* A = (bf16_t*)(a.ws + WS_A);
    LAS float* red = (LAS float*)(lds + XL_OFF);
    for (int it = vcu; it < 2 * NS; it += G) {
        if (it >= NS) {
            if (MODE != 3) { const int r = MTOK + (it - NS); *(u32x2*)(A + (size_t)r * DM + 4 * tid) = (u32x2){0u, 0u}; }
            continue;
        }
        const int r = T + it, c = 256 * wid + 4 * lane;
        const float* mod = MOD + (size_t)(1 + (it >> 2)) * NMODW;
        const float* sl = (const float*)(a.ws + WS_SL) + (size_t)it * DM + c;
        f32x4 sv[NSLAB];
#pragma unroll
        for (int q = 0; q < NSLAB; ++q) sv[q] = *(const f32x4*)(sl + (size_t)q * 128 * DM);
        f32x4 xo;
        if (MODE == 1) xo = *(const f32x4*)(a.in[I_XS] + (size_t)it * DM + c);
        else { const u32x2 w = *(const u32x2*)(XR + (size_t)r * DM + c); xo = (f32x4){__builtin_bit_cast(float, w.x << 16), __builtin_bit_cast(float, w.x & 0xffff0000u), __builtin_bit_cast(float, w.y << 16), __builtin_bit_cast(float, w.y & 0xffff0000u)}; }
        const f32x4 gt = *(const f32x4*)(mod + gate_i * DM + c), np = *(const f32x4*)(npost + c);
        f32x4 f = sv[0];
#pragma unroll
        for (int q = 1; q < NSLAB; ++q) f += sv[q];
        const float ssw = wave_sum((f[0] * f[0] + f[1] * f[1]) + (f[2] * f[2] + f[3] * f[3]));
        __syncthreads();
        if (lane == 0) red[wid] = ssw;
        __syncthreads();
        float ss = 0.f;
#pragma unroll
        for (int w = 0; w < 8; ++w) ss += red[w];
        const float rinv = __builtin_amdgcn_rsqf(ss * (1.0f / DM) + EPS) * gsc;
        const f32x4 x = xo + gt * (f * rinv * np);
        if (MODE == 3) { *(f32x4*)(a.out + O_Y + (size_t)r * DM + c) = x; continue; }
        *(u32x2*)(XR + (size_t)r * DM + c) = (u32x2){cvt_pk_bf16(x[0], x[1]), cvt_pk_bf16(x[2], x[3])};
        const f32x4 npr = *(const f32x4*)(npre + c), sc = *(const f32x4*)(mod + scale_i * DM + c), sh = *(const f32x4*)(mod + shift_i * DM + c);
        const float ssw1 = wave_sum((x[0] * x[0] + x[1] * x[1]) + (x[2] * x[2] + x[3] * x[3]));
        if (lane == 0) red[8 + wid] = ssw1;
        __syncthreads();
        float ss1 = 0.f;
#pragma unroll
        for (int w = 0; w < 8; ++w) ss1 += red[8 + w];
        const float r1 = __builtin_amdgcn_rsqf(ss1 * (1.0f / DM) + EPS);
        const f32x4 h = (x * r1 * npr) * (sc + 1.0f) + sh;
        *(u32x2*)(A + (size_t)r * DM + c) = (u32x2){cvt_pk_bf16(h[0], h[1]), cvt_pk_bf16(h[2], h[3])};
    }
}

__device__ __forceinline__ void bias_table(const Args& a, LAS float* bt, int h, int tid) {
    __syncthreads();
    if (tid < 3 * 132) { const int g = tid / 132, m = tid % 132; bt[tid] = a.in[I_RELB][(int)BKT[g][m] * 12 + g * 4 + h] * LOG2E; }
    __syncthreads();
}

template <int G, int KT0, int NKTC, bool CQ = false>
__device__ __forceinline__ void attn_group(const bf16_t* __restrict__ QN, const bf16_t* __restrict__ KN, const bf16_t* __restrict__ VT, const LAS float* bias,
                                           int T0, int r, int h, int lane, float& m_run, float& l_run, f32x4 (&o)[8]) {
    constexpr int sh = 2 * G, d = 1 << sh, step = 16 / d, SEG = T / d;
    constexpr int QB = 3;
    static_assert(NKTC % QB == 0, "tile batches");
    const int i = lane & 15, grp = lane >> 4;
    static_assert(!CQ || (G == 0 && KT0 == 0), "compact queries: group 0 only");
    const int qrel = CQ ? r + (i & 7) + 16 * (i >> 3) : 0;
    const int rr = CQ ? 0 : (r & (d - 1)), qoff = CQ ? 0 : (r >> sh);
    const bf16_t* qp = QN + (size_t)(CQ ? T0 + qrel : T0 + r + 16 * i) * AW + G * 512 + h * 128 + 8 * grp;
    bf16x8 qf[4];
#pragma unroll
    for (int ks = 0; ks < 4; ++ks) qf[ks] = *(const bf16x8*)(qp + 32 * ks);
    const int jbase = (T0 >> sh) - 128 + 16 * KT0;
    const bf16_t* kbase = KN + (size_t)(G * 4 + h) * (T * 128) + (size_t)(rr * (SEG / 16)) * 2048;
    const bf16_t* vbase = VT + (size_t)(G * 4 + h) * (T * 128) + (size_t)(rr * (SEG / 16)) * 2048;
    f32x4 s[NKTC + 1];
#pragma unroll
    for (int kb = 0; kb < NKTC; kb += QB) {
        bf16x8 kf[QB][4];
#pragma unroll
        for (int t = 0; t < QB; ++t) {
            int tile = (jbase >> 4) + kb + t; tile = tile < 0 ? 0 : tile;
            const bf16_t* kp = kbase + (size_t)tile * 2048 + lane * 8;
#pragma unroll
            for (int ks = 0; ks < 4; ++ks) kf[t][ks] = *(const bf16x8*)(kp + 512 * ks);
        }
        __builtin_amdgcn_sched_barrier(0);
#pragma unroll
        for (int t = 0; t < QB; ++t) {
            f32x4 c = {0.f, 0.f, 0.f, 0.f};
#pragma unroll
            for (int ks = 0; ks < 4; ++ks) c = __builtin_amdgcn_mfma_f32_16x16x32_bf16(kf[t][ks], qf[ks], c, 0, 0, 0);
            s[kb + t] = c;
        }
        __builtin_amdgcn_sched_barrier(0);
    }
    s[NKTC] = (f32x4){0.f, 0.f, 0.f, 0.f};
    float mx = -1e30f;
    const int mq = (CQ ? qrel : qoff + step * i) + 128 - 16 * KT0 - 4 * grp;
#pragma unroll
    for (int kt = 0; kt < NKTC; ++kt)
#pragma unroll
        for (int reg = 0; reg < 4; ++reg) {
            const int kk = 16 * kt + 4 * grp + reg, mm = mq - 16 * kt - reg;
            const bool valid = ((unsigned)mm <= 128u) && (jbase + kk >= 0);
            const int mi = mm < 0 ? 0 : (mm > 128 ? 128 : mm);
            const float v = valid ? s[kt][reg] + bias[mi] : -__builtin_inff();
            s[kt][reg] = v; mx = fmaxf(mx, v);
        }
    mx = fmaxf(mx, __shfl_xor(mx, 16)); mx = fmaxf(mx, __shfl_xor(mx, 32));
    const float m_new = fmaxf(m_run, mx), alpha = ex2(m_run - m_new);
    float ls = 0.f;
#pragma unroll
    for (int kt = 0; kt < NKTC; ++kt)
#pragma unroll
        for (int reg = 0; reg < 4; ++reg) { const float p = ex2(s[kt][reg] - m_new); s[kt][reg] = p; ls += p; }
    ls += __shfl_xor(ls, 16); ls += __shfl_xor(ls, 32);
    l_run = l_run * alpha + ls; m_run = m_new;
#pragma unroll
    for (int dt = 0; dt < 8; ++dt) o[dt] = o[dt] * alpha;
    constexpr int NKS2 = (NKTC + 1) / 2;
    constexpr int PB = 1;
#pragma unroll
    for (int kb2 = 0; kb2 < NKS2; kb2 += PB) {
        u32x2 vl[PB][8], vh[PB][8];
#pragma unroll
        for (int t = 0; t < PB; ++t) if (kb2 + t < NKS2) {
            int t0 = (jbase >> 4) + 2 * (kb2 + t), t1 = t0 + 1;
            t0 = t0 < 0 ? 0 : t0; t1 = t1 < 0 ? 0 : (t1 > SEG / 16 - 1 ? SEG / 16 - 1 : t1);
            const bf16_t* p0 = vbase + (size_t)t0 * 2048 + lane * 4; const bf16_t* p1 = vbase + (size_t)t1 * 2048 + lane * 4;
#pragma unroll
            for (int dt = 0; dt < 8; ++dt) { vl[t][dt] = *(const u32x2*)(p0 + 256 * dt); vh[t][dt] = *(const u32x2*)(p1 + 256 * dt); }
        }
        __builtin_amdgcn_sched_barrier(0);
#pragma unroll
        for (int t = 0; t < PB; ++t) if (kb2 + t < NKS2) {
            const int ks2 = kb2 + t;
            u32x4 pw;
            pw.x = cvt_pk_bf16(s[2 * ks2][0], s[2 * ks2][1]); pw.y = cvt_pk_bf16(s[2 * ks2][2], s[2 * ks2][3]);
            pw.z = cvt_pk_bf16(s[2 * ks2 + 1][0], s[2 * ks2 + 1][1]); pw.w = cvt_pk_bf16(s[2 * ks2 + 1][2], s[2 * ks2 + 1][3]);
            const bf16x8 pf = __builtin_bit_cast(bf16x8, pw);
#pragma unroll
            for (int dt = 0; dt < 8; ++dt) {
                const bf16x8 vf = __builtin_bit_cast(bf16x8, (u32x4){vl[t][dt].x, vl[t][dt].y, vh[t][dt].x, vh[t][dt].y});
                o[dt] = __builtin_amdgcn_mfma_f32_16x16x32_bf16(vf, pf, o[dt], 0, 0, 0);
            }
        }
        __builtin_amdgcn_sched_barrier(0);
    }
}

__device__ __forceinline__ void attn_prompt_unit(const Args& a, LAS unsigned char* lds, int unit, int tid, int wid, int lane) {
    const int half = unit & 1, h = (unit >> 1) & 3, T0 = (unit >> 3) * 256;
    LAS float* bt = (LAS float*)lds;
    bias_table(a, bt, h, tid);
    const bf16_t* QN = (const bf16_t*)(a.ws + WS_QN); const bf16_t* KN = (const bf16_t*)(a.ws + WS_KN); const bf16_t* VT = (const bf16_t*)(a.ws + WS_VT);
    bf16_t* ATT = (bf16_t*)(a.ws + WS_YA) + CC;
    const int r = 8 * half + wid;
    float m_run = -1e30f, l_run = 0.f; f32x4 o[8];
#pragma unroll
    for (int dt = 0; dt < 8; ++dt) o[dt] = (f32x4){0.f, 0.f, 0.f, 0.f};
    const int i = lane & 15, grp = lane >> 4, t = T0 + r + 16 * i;
    LAS float* mg = (LAS float*)(lds + 4096);
    attn_group<0, 0, 12, true>(QN, KN, VT, bt, T0 + 32 * wid, 8 * half, h, lane, m_run, l_run, o);
    { LAS float* dstq = mg + ((i & 7) * 16 + 2 * wid + (i >> 3)) * 132;
#pragma unroll
      for (int dt = 0; dt < 8; ++dt) *(LAS f32x4*)(dstq + 16 * dt + 4 * grp) = o[dt];
      if (grp == 0) { dstq[128] = m_run; dstq[129] = l_run; } }
    m_run = -1e30f; l_run = 0.f;
#pragma unroll
    for (int dt = 0; dt < 8; ++dt) o[dt] = (f32x4){0.f, 0.f, 0.f, 0.f};
    attn_group<1, 0, 12>(QN, KN, VT, bt + 132, T0, r, h, lane, m_run, l_run, o);
    attn_group<2, 0, 9>(QN, KN, VT, bt + 264, T0, r, h, lane, m_run, l_run, o);
    __syncthreads();
    { const LAS float* srcq = mg + (wid * 16 + i) * 132;
      const float m0 = srcq[128], l0 = srcq[129], mm_ = fmaxf(m_run, m0), a1 = ex2(m_run - mm_), a0 = ex2(m0 - mm_);
      l_run = l_run * a1 + l0 * a0;
#pragma unroll
      for (int dt = 0; dt < 8; ++dt) o[dt] = o[dt] * a1 + *(const LAS f32x4*)(srcq + 16 * dt + 4 * grp) * a0; }
    const float inv = 1.0f / l_run;
#pragma unroll
    for (int dt = 0; dt < 8; ++dt) { const f32x4 v = o[dt] * inv; *(u32x2*)(ATT + (size_t)t * YAW + h * 128 + 16 * dt + 4 * grp) = (u32x2){cvt_pk_bf16(v[0], v[1]), cvt_pk_bf16(v[2], v[3])}; }
}

template <int G>
__device__ __forceinline__ void attn_sample_task(const float* __restrict__ ck, const float* __restrict__ cv, const float* nk, const float* nv, const bf16_t* QN, const LAS float* bt, LAS float* pp,
                                                 int b, int h, int j, int lane, int pb0 = 0, int pb1 = 65) {
    constexpr int sh = 2 * G, W = 128 << sh, NB = 13;
    const int half = lane >> 5, sub = lane & 31;
    const bf16x4 qb = *(const bf16x4*)(QN + (size_t)(T + b * 4 + j) * AW + G * 512 + h * 128 + 4 * sub);
    const f32x4 q = {bf2f((unsigned short)qb[0]), bf2f((unsigned short)qb[1]), bf2f((unsigned short)qb[2]), bf2f((unsigned short)qb[3])};
    const size_t hb = (size_t)b * W * 512 + h * 128 + 4 * sub;
    float mr = -1e30f, l = 0.f; f32x4 o = {0.f, 0.f, 0.f, 0.f};
#pragma unroll 1
    for (int pb = pb0; pb < pb1; pb += NB) {
        f32x4 kx[NB], vx[NB];
#pragma unroll
        for (int t = 0; t < NB; ++t) {
            const int m = 2 * (pb + t) + half, mc = m <= 128 ? m : 128;
            const int idx = W + j - (mc << sh);
            const bool isnew = idx >= W;
            const size_t ro = hb + (size_t)(isnew ? idx - 4 : idx) * 512;
            kx[t] = *(const f32x4*)((isnew ? nk : ck) + ro); vx[t] = *(const f32x4*)((isnew ? nv : cv) + ro);
        }
        __builtin_amdgcn_sched_barrier(0);
#pragma unroll
        for (int t = 0; t < NB; ++t) {
            const int m = 2 * (pb + t) + half; const bool valid = m <= 128; const int mc = valid ? m : 128;
            float dp = (q[0] * kx[t][0] + q[1] * kx[t][1]) + (q[2] * kx[t][2] + q[3] * kx[t][3]);
            dp += __shfl_xor(dp, 1); dp += __shfl_xor(dp, 2); dp += __shfl_xor(dp, 4); dp += __shfl_xor(dp, 8); dp += __shfl_xor(dp, 16);
            const float s = valid ? dp + bt[G * 132 + mc] : -__builtin_inff();
            const float mn = fmaxf(mr, s), al = ex2(mr - mn), p = ex2(s - mn);
            l = l * al + p; o = o * al + vx[t] * p; mr = mn;
        }
        __builtin_amdgcn_sched_barrier(0);
    }
    const float mo = __shfl_xor(mr, 32), lo = __shfl_xor(l, 32);
    const f32x4 oo = {__shfl_xor(o[0], 32), __shfl_xor(o[1], 32), __shfl_xor(o[2], 32), __shfl_xor(o[3], 32)};
    const float M = fmaxf(mr, mo), e0 = ex2(mr - M), e1 = ex2(mo - M);
    l = l * e0 + lo * e1; o = o * e0 + oo * e1;
    if (lane < 32) { if (lane == 0) { pp[0] = M; pp[1] = l; } *(LAS f32x4*)(pp + 4 + 4 * sub) = o; }
}
__device__ __forceinline__ void attn_sample_item(const Args& a, LAS unsigned char* lds, int item, int tid, int wid, int lane) {
    const int b = item >> 2, h = item & 3;
    LAS float* bt = (LAS float*)lds; LAS float* part = (LAS float*)(lds + 2048);
    bias_table(a, bt, h, tid);
    const bf16_t* QN = (const bf16_t*)(a.ws + WS_QN); bf16_t* ATT = (bf16_t*)(a.ws + WS_YA) + CC;
    if (wid < 4) { attn_sample_task<0>(a.in[I_CK0], a.in[I_CV0], a.out + O_SK0, a.out + O_SV0, QN, bt, part + wid * 132, b, h, wid, lane);
                   attn_sample_task<2>(a.in[I_CK2], a.in[I_CV2], a.out + O_SK2, a.out + O_SV2, QN, bt, part + (8 + wid) * 132, b, h, wid, lane, 0, 39); }
    else { attn_sample_task<1>(a.in[I_CK1], a.in[I_CV1], a.out + O_SK1, a.out + O_SV1, QN, bt, part + wid * 132, b, h, wid - 4, lane);
           attn_sample_task<2>(a.in[I_CK2], a.in[I_CV2], a.out + O_SK2, a.out + O_SV2, QN, bt, part + (8 + wid) * 132, b, h, wid - 4, lane, 39, 65); }
    __syncthreads();
    if (wid < 4) {
        const int j = wid;
        const LAS float* p0 = part + j * 132; const LAS float* p1 = part + (4 + j) * 132; const LAS float* p2 = part + (8 + j) * 132; const LAS float* p3 = part + (12 + j) * 132;
        const float M = fmaxf(fmaxf(p0[0], p1[0]), fmaxf(p2[0], p3[0])), e0 = ex2(p0[0] - M), e1 = ex2(p1[0] - M), e2 = ex2(p2[0] - M), e3 = ex2(p3[0] - M);
        const float inv = 1.0f / ((p0[1] * e0 + p1[1] * e1) + (p2[1] * e2 + p3[1] * e3));
        const float v0 = ((p0[4 + 2 * lane] * e0 + p1[4 + 2 * lane] * e1) + (p2[4 + 2 * lane] * e2 + p3[4 + 2 * lane] * e3)) * inv, v1 = ((p0[5 + 2 * lane] * e0 + p1[5 + 2 * lane] * e1) + (p2[5 + 2 * lane] * e2 + p3[5 + 2 * lane] * e3)) * inv;
        *(unsigned*)(ATT + (size_t)(T + b * 4 + j) * YAW + h * 128 + 2 * lane) = cvt_pk_bf16(v0, v1);
    }
    __syncthreads();
}

template <int NT, bool SAMPLE>
__device__ __forceinline__ void conv_item(const Args& a, LAS unsigned char* lds, int item, int tid, int wid, int lane) {
    const bf16_t* U = (const bf16_t*)(a.ws + WS_U); bf16_t* YN = (bf16_t*)(a.ws + WS_YA);
    LAS float* yl = (LAS float*)lds;
    __syncthreads();
    const int c0 = 2 * tid;
    f32x2 ur[NT + 30];
    const int t0 = SAMPLE ? T + item * 4 : item * NT;
#pragma unroll
    for (int i = 0; i < NT + 30; ++i) {
        if (SAMPLE) { if (i < 30) ur[i] = *(const f32x2*)(a.in[I_STC] + ((size_t)item * 30 + i) * CC + c0); else { const unsigned w = *(const unsigned*)(U + (size_t)(t0 + i - 30) * CC + c0); ur[i] = (f32x2){__builtin_bit_cast(float, w << 16), __builtin_bit_cast(float, w & 0xffff0000u)}; } }
        else { const int t = t0 - 30 + i; const unsigned w = (t >= 0) ? *(const unsigned*)(U + (size_t)t * CC + c0) : 0u; ur[i] = (f32x2){__builtin_bit_cast(float, w << 16), __builtin_bit_cast(float, w & 0xffff0000u)}; }
    }
    f32x2 y[NT];
    const f32x2 bias = *(const f32x2*)(a.in[I_DWB] + c0);
#pragma unroll
    for (int ti = 0; ti < NT; ++ti) y[ti] = bias;
#pragma unroll
    for (int k = 0; k < 31; ++k) { const f32x2 w = *(const f32x2*)(a.in[I_DWK] + (size_t)k * CC + c0);
#pragma unroll
        for (int ti = 0; ti < NT; ++ti) y[ti] += w * ur[ti + k]; }
#pragma unroll
    for (int ti = 0; ti < NT; ++ti) *(LAS f32x2*)(yl + ti * CC + c0) = y[ti];
    __syncthreads();
    for (int ti = wid; ti < NT; ti += 8) {
        f32x4 v[4]; float s = 0.f;
#pragma unroll
        for (int q = 0; q < 4; ++q) { v[q] = *(const LAS f32x4*)(yl + ti * CC + 4 * lane + 256 * q); s += (v[q][0] + v[q][1]) + (v[q][2] + v[q][3]); }
        const float mu = wave_sum(s) * (1.0f / CC); float s2 = 0.f;
#pragma unroll
        for (int q = 0; q < 4; ++q) { v[q] = v[q] - mu; s2 += (v[q][0] * v[q][0] + v[q][1] * v[q][1]) + (v[q][2] * v[q][2] + v[q][3] * v[q][3]); }
        const float rstd = __builtin_amdgcn_rsqf(wave_sum(s2) * (1.0f / CC) + EPS);
#pragma unroll
        for (int q = 0; q < 4; ++q) { const int c = 4 * lane + 256 * q;
            const f32x4 g = *(const f32x4*)(a.in[I_LNG] + c), bb = *(const f32x4*)(a.in[I_LNB] + c);
            f32x4 yn = v[q] * rstd * g + bb; yn = yn * sigm4(yn);
            *(u32x2*)(YN + (size_t)(t0 + ti) * YAW + c) = (u32x2){cvt_pk_bf16(yn[0], yn[1]), cvt_pk_bf16(yn[2], yn[3])}; }
    }
    __syncthreads();
}

constexpr int N_PHASES = 13;
__global__ void __launch_bounds__(NWAVES * 64, 2) mk_fwd(Args args) {
    extern __shared__ __attribute__((aligned(16))) unsigned char lds_raw[];
    LAS unsigned char* lds = (LAS unsigned char*)lds_raw;
    volatile LAS unsigned* MISC = (volatile LAS unsigned*)(lds + MISC_OFF);
    const int tid = threadIdx.x, lane = tid & 63, wid = __builtin_amdgcn_readfirstlane(tid >> 6);
    const int G = gridDim.x; const int bx = blockIdx.x; const int vcu = (G % 8 == 0) ? (bx % 8) * (G / 8) + bx / 8 : bx;
    unsigned char* ws = args.ws;
    gu32* ctl = (gu32*)(ws + WS_CTL);
    for (int u = tid; u < (LDS_BYTES - LDSCTL_OFF) / 4; u += NWAVES * 64) ((LAS unsigned*)(lds + LDSCTL_OFF))[u] = 0u;
    __syncthreads();
    XcdBarrier bar; bar.bar = (unsigned*)(ctl + CW_BAR); bar.x = 0; bar.st = nullptr;
    if (MK_N_LAUNCHES == 1) bar = xcd_barrier_post((unsigned*)(ctl + CW_BAR), MISC + 8);
    const int lo = args.ph_lo, hi = args.ph_hi;
#ifndef PH_MASK
#define PH_MASK 0x1fff
#endif
#define IN(k) ((((PH_MASK) >> (k)) & 1) && lo <= (k) && (k) < hi)
#define SEAM(k) do { if (IN(k) && IN((k) + 1)) xcd_barrier(bar); } while (0)

    bf16_t* A = (bf16_t*)(ws + WS_A); float* F = (float*)(ws + WS_F); bf16_t* GH = (bf16_t*)(ws + WS_GH);

    if (IN(0)) { p0_adaln(args, lds, vcu, G, tid, wid, lane); }
    SEAM(0);
    if (IN(1)) { row_pass<0, 0>(args, vcu, G, wid, lane, nullptr, 0, 0.f, args.in[I_F1NPRE], 0, 1); p0_weights(args, lds, vcu, G, tid, wid, lane); }
    SEAM(1);
    if (IN(2)) { pg8::SimpleSched S; S.init(A, ws + WS_W13A, MP, 2 * FF, DM, G, bx); pg8::EpiSwiglu E{GH}; pg8::gemm_phase(lds, DM, S, E); if ((1452 - bx + G - 1) / G < (1452 + G - 1) / G) copy_filler(args, lds, tid, wid, lane, FILL_UP); }
    SEAM(2);
    if (IN(3)) { pg8::DownSched S; S.init(GH, ws + WS_W2A, FF, 22, G, bx);
        pg8::EpiDownFused<1> E{(float*)(ws + WS_SL), args.in[I_XP], (bf16_t*)(ws + WS_XR), A, args.out, (const float*)(ws + WS_MOD), args.in[I_F1NPOST], args.in[I_MNPRE], (float*)(ws + WS_XS), (unsigned*)(ctl + CW_XC), lds + XL_OFF};
        pg8::gemm_phase(lds, FF, S, E); }
    SEAM(3);
    if (IN(4)) { sample_rows<1, 22>(args, lds, vcu, G, tid, wid, lane, args.in[I_F1NPOST], 2, 0.5f, args.in[I_MNPRE], 3, 4); }
    SEAM(4);
    if (IN(5)) { pg8::MixSched S; S.init(A, ws + WS_WIN, G, bx);
        pg8::EpiMixIn E{(bf16_t*)(ws + WS_U), (bf16_t*)(ws + WS_QN), (bf16_t*)(ws + WS_KN), (bf16_t*)(ws + WS_VT), (bf16_t*)(ws + WS_SGC), (bf16_t*)(ws + WS_SGA), args.out};
        pg8::gemm_phase(lds, DM, S, E); if ((pg8::MixSched::N2 - bx + G - 1) / G < (pg8::MixSched::N2 + G - 1) / G) copy_filler(args, lds, tid, wid, lane, FILL_UP); }
    SEAM(5);
    if (IN(6)) {
#ifndef P6_PARTS
#define P6_PARTS 15
#endif
        if (P6_PARTS & 1) for (int u = vcu; u < 256; u += G) attn_prompt_unit(args, lds, u, tid, wid, lane);
        if (G == 256) {
            if (vcu < 128) { if (P6_PARTS & 2) attn_sample_item(args, lds, vcu, tid, wid, lane); }
            else { for (int e = vcu - 128; e < 544; e += 128) { if (e < 512) { if (P6_PARTS & 4) conv_item<16, false>(args, lds, e, tid, wid, lane); } else { if (P6_PARTS & 8) conv_item<4, true>(args, lds, e - 512, tid, wid, lane); } } }
        } else
        for (int e = vcu; e < 128 + 512 + 32; e += G) {
            if (e < 128) { if (P6_PARTS & 2) attn_sample_item(args, lds, e, tid, wid, lane); }
            else if (e < 128 + 512) { if (P6_PARTS & 4) conv_item<16, false>(args, lds, e - 128, tid, wid, lane); }
            else { if (P6_PARTS & 8) conv_item<4, true>(args, lds, e - 640, tid, wid, lane); }
        }
        { bf16_t* YA = (bf16_t*)(ws + WS_YA);
          for (int i = bx * 512 + tid; i < 128 * YAW / 8; i += G * 512) *(u32x4*)(YA + (size_t)MTOK * YAW + 8 * i) = (u32x4){0u, 0u, 0u, 0u}; }
    }
    SEAM(6);
    if (IN(7)) { pg8::PairSched S; S.init(ws + WS_YA, ws + WS_WCO, G, bx); pg8::EpiMixPair E{(const bf16_t*)(ws + WS_SGC), (const bf16_t*)(ws + WS_SGA), (bf16_t*)(ws + WS_MG)};
        pg8::gemm_phase(lds, YAW, S, E); if (bx >= 8) copy_filler(args, lds, tid, wid, lane, FILL_7A + FILL_7B); }
    SEAM(7);
    if (IN(8)) { pg8::DownSched S; S.init(ws + WS_MG, ws + WS_WOUT, DM, 8, G, bx);
        pg8::EpiDownFused<2> E{(float*)(ws + WS_SL), nullptr, (bf16_t*)(ws + WS_XR), A, args.out, (const float*)(ws + WS_MOD), args.in[I_MNPOST], args.in[I_F2NPRE], (float*)(ws + WS_XS) + 2 * 32 * 256 * 8, (unsigned*)(ctl + CW_XC) + 2 * 32 * 64, lds + XL_OFF};
        pg8::gemm_phase(lds, DM, S, E); if (bx >= 64) copy_filler(args, lds, tid, wid, lane, FILL_8); }
    SEAM(8);
    if (IN(9)) { sample_rows<2, 8>(args, lds, vcu, G, tid, wid, lane, args.in[I_MNPOST], 5, 1.0f, args.in[I_F2NPRE], 6, 7); }
    SEAM(9);
    if (IN(10)) { pg8::SimpleSched S; S.init(A, ws + WS_W13B, MP, 2 * FF, DM, G, bx); pg8::EpiSwiglu E{GH}; pg8::gemm_phase(lds, DM, S, E); if ((1452 - bx + G - 1) / G < (1452 + G - 1) / G) copy_filler(args, lds, tid, wid, lane, FILL_UP); }
    SEAM(10);
    if (IN(11)) { pg8::DownSched S; S.init(GH, ws + WS_W2B, FF, 22, G, bx);
        pg8::EpiDownFused<3> E{(float*)(ws + WS_SL), nullptr, (bf16_t*)(ws + WS_XR), A, args.out, (const float*)(ws + WS_MOD), args.in[I_F2NPOST], nullptr, (float*)(ws + WS_XS) + 4 * 32 * 256 * 8, (unsigned*)(ctl + CW_XC) + 4 * 32 * 64, lds + XL_OFF};
        pg8::gemm_phase(lds, FF, S, E); }
    if (IN(11) && IN(12)) xcd_barrier(bar, vcu >= 128 && G == 256);
    if (IN(12)) { const int lane_ = (int)__builtin_amdgcn_mbcnt_hi(~0u, __builtin_amdgcn_mbcnt_lo(~0u, 0u)), tid_ = (wid << 6) | lane_;
        sample_rows<3, 22>(args, lds, vcu, G, tid_, wid, lane_, args.in[I_F2NPOST], 8, 0.5f, nullptr, 0, 0); copy_filler(args, lds, tid_, wid, lane_, 1 << 30); }
#undef IN
#undef SEAM
}

extern "C" void kernel_launch(void* const* d_in, const int* in_sizes, int n_in, void* d_out, int out_size, void* d_ws, size_t ws_size, hipStream_t stream) {
    static int grid = 0;
    if (grid == 0) {
        if (n_in != 34 || (size_t)out_size != O_END || ws_size < WS_END) { fprintf(stderr, "kernel_launch: unexpected shapes: n_in %d out %d ws %zu (need %zu); nothing launched\n", n_in, out_size, ws_size, (size_t)WS_END); grid = -1; return; }
        int dev = 0, cus = 0, per_cu = 0;
        if (hipGetDevice(&dev) != hipSuccess || hipDeviceGetAttribute(&cus, hipDeviceAttributeMultiprocessorCount, dev) != hipSuccess) { grid = -1; return; }
        if (hipFuncSetAttribute((const void*)mk_fwd, hipFuncAttributeMaxDynamicSharedMemorySize, LDS_BYTES) != hipSuccess) { fprintf(stderr, "kernel_launch: hipFuncSetAttribute failed\n"); grid = -1; return; }
        if (hipOccupancyMaxActiveBlocksPerMultiprocessor(&per_cu, (const void*)mk_fwd, NWAVES * 64, LDS_BYTES) != hipSuccess || per_cu < 1) { fprintf(stderr, "kernel_launch: occupancy query says %d\n", per_cu); per_cu = 1; }
        (void)hipGetLastError();
        grid = cus * (per_cu < 1 ? 1 : 1);
    }
    if (grid < 0) return;
    (void)hipMemsetAsync((char*)d_ws + WS_CTL, 0, CTL_ZERO_BYTES, stream);
    Args a{};
    for (int i = 0; i < 34; ++i) a.in[i] = (const float*)d_in[i];
    a.out = (float*)d_out; a.ws = (unsigned char*)d_ws;
    if (MK_N_LAUNCHES == 1) { a.ph_lo = 0; a.ph_hi = N_PHASES; a.li = 0; hipLaunchKernelGGL(mk_fwd, dim3(grid), dim3(NWAVES * 64), LDS_BYTES, stream, a); }
    else for (int li = 0; li < N_PHASES; ++li) { a.ph_lo = li; a.ph_hi = li + 1; a.li = li; hipLaunchKernelGGL(mk_fwd, dim3(grid), dim3(NWAVES * 64), LDS_BYTES, stream, a); }
}
```
